# Optimizing an MI355X kernel written in HIP

```python
import math
import jax
import jax.numpy as jnp
from jax import lax
import numpy as np

D_MODEL = 1024
BATCH = 8
SEQ = 4096
DEPTH = 2
DEC_BATCH = 128
DEC_SEQ = 4
PAST_LEN = 16384
PAGE_SIZE = 128

N_EVEN = (DEPTH + 1) // 2
N_ODD = DEPTH // 2

D_FF = 2816
A_CHUNK = 128
A_HEADS = 8
A_WIDTH = D_MODEL
A_HEAD_DIM = A_WIDTH // A_HEADS
B_HEADS = 16
B_HEAD_DIM = 64
B_INNER = B_HEADS * B_HEAD_DIM
B_GROUPS = 2
B_STATE = 128
B_CONV = 4
B_CHUNK = 128
B_CONV_DIM = B_INNER + 2 * B_GROUPS * B_STATE
C_WIDTH = D_MODEL
C_WINDOWS = (2, 4, 8, 16)
C_GROUPS = len(C_WINDOWS)
C_GROUP_DIM = C_WIDTH // C_GROUPS
C_STATE_LEN = max(C_WINDOWS) - 1
D_Q_HEADS = 16
D_KV_HEADS = 4
D_HEAD_DIM = 64
D_WINDOW = 128
REL_BUCKETS = 32
REL_MAX_DIST = 128

EVEN_IN = 2 * A_WIDTH + B_INNER + B_CONV_DIM + B_HEADS
EVEN_MIX = A_WIDTH + B_INNER
ODD_IN = C_WIDTH + (D_Q_HEADS + 2 * D_KV_HEADS) * D_HEAD_DIM
ODD_MIX = C_WIDTH + D_Q_HEADS * D_HEAD_DIM
EPS = 1e-6
NEG = -1e30

kernel_name = 'hybrid_gmlp_ssd_pool_swa_decoder_step'


def rms_norm(x, g):
    xf = x.astype(jnp.float32)
    y = xf * lax.rsqrt(jnp.mean(xf * xf, axis=-1, keepdims=True) + EPS)
    return (y * g.astype(jnp.float32)).astype(x.dtype)


def layer_norm(x, g, b):
    xf = x.astype(jnp.float32)
    mu = jnp.mean(xf, axis=-1, keepdims=True)
    var = jnp.mean(jnp.square(xf - mu), axis=-1, keepdims=True)
    y = (xf - mu) * lax.rsqrt(var + EPS) * g.astype(jnp.float32) + b.astype(jnp.float32)
    return y.astype(x.dtype)


def swiglu(x, w_gu, w_down):
    gate, up = jnp.split(x @ w_gu, 2, axis=-1)
    return (jax.nn.silu(gate) * up) @ w_down


def macaron_half(h, g, w_gu, w_down):
    return h + 0.5 * swiglu(rms_norm(h, g), w_gu, w_down)


def t5_bucket(dist):
    n = np.maximum(dist, 0)
    max_exact = REL_BUCKETS // 2
    n_safe = np.maximum(n, 1).astype(np.float32)
    scale = np.float32((REL_BUCKETS - max_exact) / math.log(REL_MAX_DIST / max_exact))
    large = max_exact + (np.log(n_safe / max_exact) * scale).astype(np.int32)
    large = np.minimum(large, REL_BUCKETS - 1)
    return np.where(n < max_exact, n, large).astype(np.int32)


def band_bias(rel_table, q_pos, k_pos):
    bucket = t5_bucket(q_pos[:, None] - k_pos[None, :])
    return jnp.transpose(rel_table[bucket].astype(jnp.float32), (2, 0, 1))


def mixer_a(proj, ln_g, ln_b, w_s, b_s, n_chunk):
    b, L, _ = proj.shape
    u, v = jnp.split(jax.nn.gelu(proj), 2, axis=-1)
    v = layer_norm(v, ln_g, ln_b)
    shp = (b, L // n_chunk, n_chunk, A_HEADS, A_HEAD_DIM)
    causal = np.tril(np.ones((n_chunk, n_chunk), dtype=bool))
    w = jnp.where(causal, w_s[:, :n_chunk, :n_chunk], 0)
    gate = jnp.einsum('hij,bcjhe->bcihe', w, v.reshape(shp)) + b_s[:, :n_chunk].T[None, None, :, :, None]
    y = u.reshape(shp) * gate
    return y.reshape(b, L, A_WIDTH), v


def short_conv(xbc, conv_state, w, bias):
    L = xbc.shape[1]
    ext = jnp.concatenate([conv_state.astype(xbc.dtype), xbc], axis=1)
    out = bias
    for tap in range(B_CONV):
        out = out + ext[:, tap:tap + L] * w[tap]
    return jax.nn.silu(out), ext[:, ext.shape[1] - (B_CONV - 1):]


def ssd_scan(x, dt, a, bm, cm, init_state, chunk):
    f32 = jnp.float32
    b, L, H, P = x.shape
    G, N = bm.shape[2], bm.shape[3]
    R = H // G
    nc = L // chunk
    xd = (x.astype(f32) * dt[..., None]).reshape(b, nc, chunk, G, R, P)
    da = (dt * a).reshape(b, nc, chunk, G, R)
    bmc = bm.astype(f32).reshape(b, nc, chunk, G, N)
    cmc = cm.astype(f32).reshape(b, nc, chunk, G, N)
    a_cum = jnp.cumsum(da, axis=2)
    seg = a_cum[:, :, :, None] - a_cum[:, :, None, :]
    causal = np.tril(np.ones((chunk, chunk), dtype=bool))[None, None, :, :, None, None]
    lmat = jnp.exp(jnp.where(causal, seg, -jnp.inf))
    cb = jnp.einsum('bcign,bcjgn->bcijg', cmc, bmc)
    y_diag = jnp.einsum('bcijg,bcijgr,bcjgrp->bcigrp', cb, lmat, xd)
    decay = jnp.exp(a_cum[:, :, -1:] - a_cum)
    states = jnp.einsum('bcjgn,bcjgr,bcjgrp->bcgrpn', bmc, decay, xd)
    chunk_decay = jnp.exp(a_cum[:, :, -1])
    s0 = init_state.astype(f32).reshape(b, G, R, P, N)

    def step(s, inp):
        st, dec = inp
        return s * dec[..., None, None] + st, s

    final, prev = lax.scan(step, s0, (jnp.moveaxis(states, 1, 0), jnp.moveaxis(chunk_decay, 1, 0)))
    prev = jnp.moveaxis(prev, 0, 1)
    y_off = jnp.einsum('bcign,bcgrpn,bcigr->bcigrp', cmc, prev, jnp.exp(a_cum))
    y = (y_diag + y_off).reshape(b, L, H, P)
    return y, final.reshape(b, H, P, N)


def mixer_b(proj, conv_state, ssm_state, conv_w, conv_b, dt_bias, a_log, d_skip, norm_g, chunk):
    f32 = jnp.float32
    b, L, _ = proj.shape
    z = proj[..., :B_INNER]
    xbc, new_conv = short_conv(proj[..., B_INNER:B_INNER + B_CONV_DIM], conv_state, conv_w, conv_b)
    dt_raw = proj[..., B_INNER + B_CONV_DIM:]
    gn = B_GROUPS * B_STATE
    xs = xbc[..., :B_INNER].reshape(b, L, B_HEADS, B_HEAD_DIM)
    bm = xbc[..., B_INNER:B_INNER + gn].reshape(b, L, B_GROUPS, B_STATE)
    cm = xbc[..., B_INNER + gn:].reshape(b, L, B_GROUPS, B_STATE)
    dt = jax.nn.softplus(dt_raw.astype(f32) + dt_bias.astype(f32))
    a = -jnp.exp(a_log.astype(f32))
    y, new_ssm = ssd_scan(xs, dt, a, bm, cm, ssm_state, chunk)
    y = y + xs.astype(f32) * d_skip.astype(f32)[:, None]
    y = y.reshape(b, L, B_INNER) * jax.nn.silu(z.astype(f32))
    yg = y.reshape(b, L, B_GROUPS, B_INNER // B_GROUPS)
    yg = yg * lax.rsqrt(jnp.mean(yg * yg, axis=-1, keepdims=True) + EPS)
    y = yg.reshape(b, L, B_INNER) * norm_g.astype(f32)
    return y.astype(proj.dtype), new_conv, new_ssm.astype(ssm_state.dtype)


def mixer_c(c_in, pool_state, start_pos, lin_w, scale):
    f32 = jnp.float32
    b, L, _ = c_in.shape
    p0 = pool_state.shape[1]
    ext = jnp.concatenate([pool_state.astype(f32), c_in.astype(f32)], axis=1)
    csum = jnp.concatenate([jnp.zeros((b, 1, C_WIDTH), f32), jnp.cumsum(ext, axis=1)], axis=1)
    hi = np.arange(p0, p0 + L) + 1
    pos = start_pos + np.arange(L)
    cur = ext[:, p0:]
    outs = []
    for gi, win in enumerate(C_WINDOWS):
        sl = slice(gi * C_GROUP_DIM, (gi + 1) * C_GROUP_DIM)
        lo = np.maximum(hi - win, 0)
        count = np.minimum(pos + 1, win).astype(np.float32)[None, :, None]
        pooled = (csum[:, hi, sl] - csum[:, lo, sl]) / count - cur[..., sl]
        outs.append(jnp.einsum('blc,cd->bld', pooled, lin_w[gi].astype(f32)))
    y = jnp.concatenate(outs, axis=-1) * scale.astype(f32)
    return y.astype(c_in.dtype), ext[:, ext.shape[1] - C_STATE_LEN:].astype(c_in.dtype)


def d_qkv(proj, q_norm, k_norm):
    b, L, _ = proj.shape
    qw = D_Q_HEADS * D_HEAD_DIM
    kw = D_KV_HEADS * D_HEAD_DIM
    q = proj[..., :qw].reshape(b, L, D_KV_HEADS, D_Q_HEADS // D_KV_HEADS, D_HEAD_DIM)
    k = proj[..., qw:qw + kw].reshape(b, L, D_KV_HEADS, D_HEAD_DIM)
    v = proj[..., qw + kw:].reshape(b, L, D_KV_HEADS, D_HEAD_DIM)
    return rms_norm(q, q_norm), rms_norm(k, k_norm), v


def sink_attention(q, k, v, bias, valid, sinks):
    f32 = jnp.float32
    grp, lq, lk = q.shape[3], q.shape[1], k.shape[1]
    s = jnp.einsum('bqhgd,bkhd->bhgqk', q.astype(f32), k.astype(f32)) * (D_HEAD_DIM ** -0.5)
    s = jnp.where(valid, s + bias.reshape(D_KV_HEADS, grp, lq, lk), NEG)
    sink = sinks.astype(f32).reshape(1, D_KV_HEADS, grp, 1, 1)
    m = jnp.maximum(jnp.max(s, axis=-1, keepdims=True), sink)
    p = jnp.exp(s - m)
    denom = jnp.sum(p, axis=-1, keepdims=True) + jnp.exp(sink - m)
    o = jnp.einsum('bhgqk,bkhd->bqhgd', p / denom, v.astype(f32))
    return o.astype(v.dtype)


def swa_prompt(q, k, v, rel_table, sinks):
    b, S = q.shape[0], q.shape[1]
    W = D_WINDOW
    kp = jnp.pad(k, ((0, 0), (W, 0), (0, 0), (0, 0)))
    vp = jnp.pad(v, ((0, 0), (W, 0), (0, 0), (0, 0)))
    r = np.arange(W) + W
    c = np.arange(2 * W)
    bias = band_bias(rel_table, r, c)
    dist = r[:, None] - c[None, :]
    band = (dist >= 0) & (dist < W)

    def block(i):
        start = i * W
        qb = lax.dynamic_slice_in_dim(q, start, W, axis=1)
        kb = lax.dynamic_slice_in_dim(kp, start, 2 * W, axis=1)
        vb = lax.dynamic_slice_in_dim(vp, start, 2 * W, axis=1)
        valid = band & ((start - W + c) >= 0)[None, :]
        return sink_attention(qb, kb, vb, bias, valid, sinks)

    o = lax.map(block, jnp.arange(S // W))
    return jnp.moveaxis(o, 0, 1).reshape(b, S, D_Q_HEADS * D_HEAD_DIM)


def swa_sample(q, k, v, k_buf, v_buf, rel_table, sinks, start_pos):
    b, L = q.shape[0], q.shape[1]
    nbuf = k_buf.shape[1]
    kk = jnp.concatenate([k_buf.astype(k.dtype), k], axis=1)
    vv = jnp.concatenate([v_buf.astype(v.dtype), v], axis=1)
    q_pos = start_pos + np.arange(L)
    k_pos = start_pos - nbuf + np.arange(nbuf + L)
    bias = band_bias(rel_table, q_pos, k_pos)
    dist = q_pos[:, None] - k_pos[None, :]
    valid = (dist >= 0) & (dist < D_WINDOW) & (k_pos >= 0)[None, :]
    o = sink_attention(q, kk, vv, bias, valid, sinks)
    return o.reshape(b, L, D_Q_HEADS * D_HEAD_DIM), kk[:, L:], vv[:, L:]


def even_mixer(xn, w_in, w_out, a_ln_g, a_ln_b, a_w_s, a_b_s, conv_w, conv_b, dt_bias, a_log, d_skip,
               b_norm_g, conv_state, ssm_state, a_chunk, b_chunk):
    proj = xn @ w_in
    ya, v_rows = mixer_a(proj[..., :2 * A_WIDTH], a_ln_g, a_ln_b, a_w_s, a_b_s, a_chunk)
    yb, new_conv, new_ssm = mixer_b(proj[..., 2 * A_WIDTH:], conv_state, ssm_state, conv_w, conv_b,
                                    dt_bias, a_log, d_skip, b_norm_g, b_chunk)
    y = jnp.concatenate([ya, yb.astype(ya.dtype)], axis=-1) @ w_out
    return y, v_rows, new_conv, new_ssm


def odd_mixer(xn, w_in, w_out, c_lin_w, c_scale, q_norm, k_norm, sinks, rel_table, pool_state, k_buf,
              v_buf, start_pos):
    proj = xn @ w_in
    yc, new_pool = mixer_c(proj[..., :C_WIDTH], pool_state, start_pos, c_lin_w, c_scale)
    q, k, v = d_qkv(proj[..., C_WIDTH:], q_norm, k_norm)
    if k_buf is None:
        yd = swa_prompt(q, k, v, rel_table, sinks)
        new_k = k[:, k.shape[1] - D_WINDOW:]
        new_v = v[:, v.shape[1] - D_WINDOW:]
    else:
        yd, new_k, new_v = swa_sample(q, k, v, k_buf, v_buf, rel_table, sinks, start_pos)
    y = jnp.concatenate([yc, yd.astype(yc.dtype)], axis=-1) @ w_out
    return y, new_pool, new_k, new_v


def setup_inputs(seed: int = 0) -> dict:
    key = jax.random.key(seed)
    it = iter(list(jax.random.split(key, 40)))
    f32 = jnp.float32

    def nrm(shape, scale):
        return jax.random.normal(next(it), shape, f32) * scale

    def gain(shape):
        return 1.0 + 0.1 * jax.random.normal(next(it), shape, f32)

    win_buf = min(D_WINDOW, PAST_LEN)
    inp = {}
    inp['x_prompt'] = nrm((BATCH, SEQ, D_MODEL), 1.0)
    inp['x_sample'] = nrm((DEC_BATCH, DEC_SEQ, D_MODEL), 1.0)
    inp['state_ssm'] = nrm((N_EVEN, DEC_BATCH, B_HEADS, B_HEAD_DIM, B_STATE), 0.5)
    inp['state_conv'] = nrm((N_EVEN, DEC_BATCH, B_CONV - 1, B_CONV_DIM), 1.0)
    inp['state_pool'] = nrm((N_ODD, DEC_BATCH, C_STATE_LEN, C_WIDTH), 1.0)
    inp['cache_k_win'] = nrm((N_ODD, DEC_BATCH, win_buf, D_KV_HEADS, D_HEAD_DIM), 1.0)
    inp['cache_v_win'] = nrm((N_ODD, DEC_BATCH, win_buf, D_KV_HEADS, D_HEAD_DIM), 1.0)
    inp['ffn1_norm'] = gain((DEPTH, D_MODEL))
    inp['ffn1_w_gu'] = nrm((DEPTH, D_MODEL, 2 * D_FF), D_MODEL ** -0.5)
    inp['ffn1_w_down'] = nrm((DEPTH, D_FF, D_MODEL), D_FF ** -0.5)
    inp['mix_norm'] = gain((DEPTH, D_MODEL))
    inp['ffn2_norm'] = gain((DEPTH, D_MODEL))
    inp['ffn2_w_gu'] = nrm((DEPTH, D_MODEL, 2 * D_FF), D_MODEL ** -0.5)
    inp['ffn2_w_down'] = nrm((DEPTH, D_FF, D_MODEL), D_FF ** -0.5)
    inp['ev_w_in'] = nrm((N_EVEN, D_MODEL, EVEN_IN), D_MODEL ** -0.5)
    inp['ev_w_out'] = nrm((N_EVEN, EVEN_MIX, D_MODEL), EVEN_MIX ** -0.5)
    inp['a_ln_g'] = gain((N_EVEN, A_WIDTH))
    inp['a_ln_b'] = nrm((N_EVEN, A_WIDTH), 0.02)
    inp['a_w_s'] = nrm((N_EVEN, A_HEADS, A_CHUNK, A_CHUNK), A_CHUNK ** -0.5)
    inp['a_b_s'] = gain((N_EVEN, A_HEADS, A_CHUNK))
    inp['b_conv_w'] = nrm((N_EVEN, B_CONV, B_CONV_DIM), B_CONV ** -0.5)
    inp['b_conv_b'] = nrm((N_EVEN, B_CONV_DIM), 0.02)
    dt0 = jnp.exp(jax.random.uniform(next(it), (N_EVEN, B_HEADS), f32, math.log(1e-3), math.log(1e-1)))
    inp['b_dt_bias'] = dt0 + jnp.log(-jnp.expm1(-dt0))
    inp['b_a_log'] = jnp.log(jax.random.uniform(next(it), (N_EVEN, B_HEADS), f32, 1.0, 16.0))
    inp['b_d_skip'] = gain((N_EVEN, B_HEADS))
    inp['b_norm_g'] = gain((N_EVEN, B_INNER))
    inp['od_w_in'] = nrm((N_ODD, D_MODEL, ODD_IN), D_MODEL ** -0.5)
    inp['od_w_out'] = nrm((N_ODD, ODD_MIX, D_MODEL), ODD_MIX ** -0.5)
    inp['c_lin_w'] = nrm((N_ODD, C_GROUPS, C_GROUP_DIM, C_GROUP_DIM), C_GROUP_DIM ** -0.5)
    inp['c_scale'] = gain((N_ODD, C_WIDTH))
    inp['d_q_norm'] = gain((N_ODD, D_HEAD_DIM))
    inp['d_k_norm'] = gain((N_ODD, D_HEAD_DIM))
    inp['d_sinks'] = nrm((N_ODD, D_Q_HEADS), 0.5)
    inp['rel_bias_table'] = nrm((REL_BUCKETS, D_Q_HEADS), 0.5)
    return inp


def reference(x_prompt, x_sample, state_ssm, state_conv, state_pool, cache_k_win, cache_v_win,
              ffn1_norm, ffn1_w_gu, ffn1_w_down, mix_norm, ffn2_norm, ffn2_w_gu, ffn2_w_down,
              ev_w_in, ev_w_out, a_ln_g, a_ln_b, a_w_s, a_b_s, b_conv_w, b_conv_b, b_dt_bias, b_a_log,
              b_d_skip, b_norm_g, od_w_in, od_w_out, c_lin_w, c_scale, d_q_norm, d_k_norm, d_sinks,
              rel_bias_table):
    hp, hs = x_prompt, x_sample
    bp = x_prompt.shape[0]
    new_a_v_s, new_ssm_p, new_ssm_s, new_conv_p, new_conv_s = [], [], [], [], []
    new_pool_p, new_pool_s, new_k_p, new_k_s, new_v_p, new_v_s = [], [], [], [], [], []
    for layer in range(DEPTH):
        i = layer // 2
        hp = macaron_half(hp, ffn1_norm[layer], ffn1_w_gu[layer], ffn1_w_down[layer])
        hs = macaron_half(hs, ffn1_norm[layer], ffn1_w_gu[layer], ffn1_w_down[layer])
        xp = rms_norm(hp, mix_norm[layer])
        xs = rms_norm(hs, mix_norm[layer])
        if layer % 2 == 0:
            ev = (ev_w_in[i], ev_w_out[i], a_ln_g[i], a_ln_b[i], a_w_s[i], a_b_s[i], b_conv_w[i],
                  b_conv_b[i], b_dt_bias[i], b_a_log[i], b_d_skip[i], b_norm_g[i])
            yp, _, conv_p, ssm_p = even_mixer(
                xp, *ev, jnp.zeros((bp, B_CONV - 1, B_CONV_DIM), xp.dtype),
                jnp.zeros((bp, B_HEADS, B_HEAD_DIM, B_STATE), jnp.float32), A_CHUNK, B_CHUNK)
            ys, v_rows_s, conv_s, ssm_s = even_mixer(
                xs, *ev, state_conv[i], state_ssm[i], xs.shape[1], xs.shape[1])
            new_a_v_s.append(v_rows_s)
            new_ssm_p.append(ssm_p)
            new_ssm_s.append(ssm_s)
            new_conv_p.append(conv_p)
            new_conv_s.append(conv_s)
        else:
            od = (od_w_in[i], od_w_out[i], c_lin_w[i], c_scale[i], d_q_norm[i], d_k_norm[i], d_sinks[i],
                  rel_bias_table)
            yp, pool_p, k_p, v_p = odd_mixer(
                xp, *od, jnp.zeros((bp, 0, C_WIDTH), xp.dtype), None, None, 0)
            ys, pool_s, k_s, v_s = odd_mixer(
                xs, *od, state_pool[i], cache_k_win[i], cache_v_win[i], PAST_LEN)
            new_pool_p.append(pool_p)
            new_pool_s.append(pool_s)
            new_k_p.append(k_p)
            new_k_s.append(k_s)
            new_v_p.append(v_p)
            new_v_s.append(v_s)
        hp = hp + yp
        hs = hs + ys
        hp = macaron_half(hp, ffn2_norm[layer], ffn2_w_gu[layer], ffn2_w_down[layer])
        hs = macaron_half(hs, ffn2_norm[layer], ffn2_w_gu[layer], ffn2_w_down[layer])
    return (hp, hs, jnp.stack(new_a_v_s), jnp.stack(new_ssm_p), jnp.stack(new_ssm_s),
            jnp.stack(new_conv_p), jnp.stack(new_conv_s), jnp.stack(new_pool_p), jnp.stack(new_pool_s),
            jnp.stack(new_k_p), jnp.stack(new_k_s), jnp.stack(new_v_p), jnp.stack(new_v_s))
```

```cpp
#include <hip/hip_runtime.h>
#include <hip/hip_cooperative_groups.h>
#include <cstdio>
#include <cstdint>
namespace cg = cooperative_groups;

#define LAS __attribute__((address_space(3)))
#define GAS __attribute__((address_space(1)))
template <class T> __device__ __forceinline__ T* as_global(T* p) { return (T*)(GAS T*)p; }
typedef unsigned short bf16_t;
typedef short bf16x8 __attribute__((ext_vector_type(8)));
typedef float f32x4 __attribute__((ext_vector_type(4)));
typedef float f32x2 __attribute__((ext_vector_type(2)));
typedef unsigned u32x4 __attribute__((ext_vector_type(4)));
typedef unsigned u32x2 __attribute__((ext_vector_type(2)));

constexpr int DM = 1024, MP = 32768, MS = 512, MT = MP + MS;
constexpr int DFF = 2816;
constexpr int EV_N = 4864, EV_PITCH = 4864;
constexpr int OD_N = 2560, OD_PITCH = 3584;
constexpr float EPS = 1e-6f;
constexpr int NWAVES = 8, NTHREADS = 512;
constexpr int LDS_BYTES = 147456;

constexpr size_t O_Y = 0;
constexpr size_t O_AV = (size_t)MT * DM;
constexpr size_t O_SSM_P = O_AV + 524288;
constexpr size_t O_SSM_S = O_SSM_P + 1048576;
constexpr size_t O_CONV_P = O_SSM_S + 16777216;
constexpr size_t O_CONV_S = O_CONV_P + 36864;
constexpr size_t O_POOL_P = O_CONV_S + 589824;
constexpr size_t O_POOL_S = O_POOL_P + 122880;
constexpr size_t O_K_P = O_POOL_S + 1966080;
constexpr size_t O_K_S = O_K_P + 262144;
constexpr size_t O_V_P = O_K_S + 4194304;
constexpr size_t O_V_S = O_V_P + 262144;
constexpr size_t O_END = O_V_S + 4194304;

constexpr size_t WS_WMB = 65536;
constexpr size_t WS_RSW = 524288;
constexpr size_t WS_WGU = 1u << 20;
constexpr size_t SZ_WGU = (size_t)5632 * 1024 * 2;
constexpr size_t WS_WDN = WS_WGU + 4 * SZ_WGU;
constexpr size_t SZ_WDN = (size_t)1024 * 2816 * 2;
constexpr size_t WS_WINE = WS_WDN + 4 * SZ_WDN;
constexpr size_t WS_WOUTE = WS_WINE + (size_t)EV_N * 1024 * 2;
constexpr size_t WS_WINO = WS_WOUTE + (size_t)1024 * 2048 * 2;
constexpr size_t WS_WOUTO = WS_WINO + (size_t)OD_N * 1024 * 2;
constexpr size_t WS_CLIN = WS_WOUTO + (size_t)1024 * 2048 * 2;
constexpr size_t WS_XB = WS_CLIN + (size_t)4 * 256 * 256 * 2;
constexpr size_t WS_RSP = WS_XB + (size_t)MT * 1024 * 2;
constexpr size_t WS_DT = WS_RSP + (size_t)MT * 16 * 4;
constexpr size_t WS_CDEC = WS_DT + (size_t)MT * 16 * 4;
constexpr size_t WS_BIG = WS_CDEC + 65536;
constexpr size_t WS_END = WS_BIG + (size_t)MT * EV_PITCH * 2;

__device__ const unsigned char T5B[128] = {0, 1, 2, 3, 4, 5, 6, 7, 8, 9, 10, 11, 12, 13, 14, 15, 16, 16, 16, 17, 17, 18, 18, 18, 19, 19, 19, 20, 20, 20, 20, 21, 21, 21, 21, 22, 22, 22, 22, 22, 23, 23, 23, 23, 23, 23, 24, 24, 24, 24, 24, 24, 25, 25, 25, 25, 25, 25, 25, 26, 26, 26, 26, 26, 26, 26, 26, 27, 27, 27, 27, 27, 27, 27, 27, 27, 27, 28, 28, 28, 28, 28, 28, 28, 28, 28, 28, 29, 29, 29, 29, 29, 29, 29, 29, 29, 29, 29, 29, 30, 30, 30, 30, 30, 30, 30, 30, 30, 30, 30, 30, 30, 30, 31, 31, 31, 31, 31, 31, 31, 31, 31, 31, 31, 31, 31, 31, 31};

__device__ __forceinline__ float bf2f(bf16_t v) { return __uint_as_float((unsigned)v << 16); }
__device__ __forceinline__ float bflo(unsigned w) { return __uint_as_float(w << 16); }
__device__ __forceinline__ float bfhi(unsigned w) { return __uint_as_float(w & 0xffff0000u); }
typedef __bf16 bf16v2 __attribute__((ext_vector_type(2)));
__device__ __forceinline__ unsigned pk2(float lo, float hi) { const f32x2 v = {lo, hi}; const bf16v2 b = __builtin_convertvector(v, bf16v2); return __builtin_bit_cast(unsigned, b); }
__device__ __forceinline__ unsigned f2bf(float f) { return pk2(f, 0.f) & 0xffffu; }
__device__ __forceinline__ float silu_f(float x) { return x * __builtin_amdgcn_rcpf(1.f + __expf(-x)); }
__device__ __forceinline__ float gelu_tanh(float x) { const float t = 1.5957691216f * (x + 0.044715f * x * x * x); return x * __builtin_amdgcn_rcpf(1.f + __expf(-t)); }
__device__ __forceinline__ float softplus_f(float x) { return fmaxf(x, 0.f) + log1pf(__expf(-fabsf(x))); }
__device__ __forceinline__ float wave_sum(float v) {
#pragma unroll
    for (int o = 1; o < 64; o <<= 1) v += __shfl_xor(v, o);
    return v;
}
__device__ __forceinline__ void unpack8(u32x4 w, float (&o)[8]) {
    o[0] = bflo(w.x); o[1] = bfhi(w.x); o[2] = bflo(w.y); o[3] = bfhi(w.y); o[4] = bflo(w.z); o[5] = bfhi(w.z); o[6] = bflo(w.w); o[7] = bfhi(w.w);
}
__device__ __forceinline__ u32x4 pack8(const float (&o)[8]) { u32x4 w; w.x = pk2(o[0], o[1]); w.y = pk2(o[2], o[3]); w.z = pk2(o[4], o[5]); w.w = pk2(o[6], o[7]); return w; }
__device__ __forceinline__ f32x4 mfma16(bf16x8 a, bf16x8 b, f32x4 c) { return __builtin_amdgcn_mfma_f32_16x16x32_bf16(a, b, c, 0, 0, 0); }
#define LDS_BF8(p) (*(const LAS bf16x8*)(p))

namespace pg8 {
constexpr int BM = 256, BK = 64, HALF = 128, HTB = HALF * BK * 2, STAGE_BYTES = 8 * HTB, NXCD = 8, WGM = 8;
__device__ __forceinline__ int lds_byte(int r, int c) { const int st = (r >> 4) * 2 + (c >> 5), rr = r & 15, cc = c & 31, ob = rr * 64 + cc * 2; return st * 1024 + (ob ^ (((ob >> 9) & 1) << 5)); }
__device__ __forceinline__ void stage_rc(int b, int& R, int& C) { const int st = b / 1024, sb = b % 1024, swz = sb ^ (((sb >> 9) & 1) << 5); R = (st >> 1) * 16 + swz / 64; C = (st & 1) * 32 + (swz % 64) / 2; }
__device__ __forceinline__ int perm32(int rho) { const int n = rho >> 4, i = rho & 15; return 8 * (i >> 2) + 4 * n + (i & 3); }

struct Unit { int pm, pn; };
struct Gemm { const bf16_t* A; const bf16_t* Bt; int lda, M, N, K; };

struct StaticOrder {
    int nM, nN, nwg, G, c;
    __device__ void init(int M, int N, int G_, int c_) { nM = M / BM; nN = N / BM; nwg = nM * nN; G = G_; c = c_; }
    __device__ bool next(int i, Unit& u) const {
        const long L = (long)i * G + c; if (L >= nwg) return false;
        int wgid = (int)L; { const int q = nwg / NXCD, r = nwg % NXCD, xcd = wgid % NXCD, off = wgid / NXCD; wgid = (xcd < r ? xcd * (q + 1) : r * (q + 1) + (xcd - r) * q) + off; }
        const int nig = WGM * nN, gid = wgid / nig, fm = gid * WGM, gsz = (nM - fm) < WGM ? (nM - fm) : WGM;
        u.pm = fm + ((wgid % nig) % gsz); u.pn = (wgid % nig) / gsz; return true;
    }
};

__device__ __forceinline__ float row_rs(const float* rsp, int row, int fq) {
    const f32x4 q = *(const f32x4*)(rsp + (size_t)row * 16 + 4 * fq);
    float s = (q[0] + q[1]) + (q[2] + q[3]); s += __shfl_xor(s, 16); s += __shfl_xor(s, 32);
    return rsqrtf(s * (1.0f / 1024.0f) + EPS);
}

__device__ __forceinline__ void row_rs8(const float* rsp, int row0, int fq, float (&rs)[8]) {
    f32x4 q[8];
#pragma unroll
    for (int r = 0; r < 8; ++r) q[r] = *(const f32x4*)(rsp + (size_t)(row0 + (r >> 2) * HALF + (r & 3) * 16) * 16 + 4 * fq);
#pragma unroll
    for (int r = 0; r < 8; ++r) { float s = (q[r][0] + q[r][1]) + (q[r][2] + q[r][3]); s += __shfl_xor(s, 16); s += __shfl_xor(s, 32); rs[r] = rsqrtf(s * (1.0f / 1024.0f) + EPS); }
}
struct EpiGU {
    static constexpr bool PERM = true;
    bf16_t* HID; const float* rsp;
    __device__ __forceinline__ void operator()(const f32x4 (&acc)[2][2][4][2], const Unit& u, int wr, int wc, int fr, int fq) const {
        const int row0 = u.pm * BM + wr * 64 + fr, col0 = u.pn * 128 + wc * 32 + 8 * fq;
        float rs8[8]; row_rs8(rsp, row0, fq, rs8);
#pragma unroll
        for (int ai = 0; ai < 2; ++ai)
#pragma unroll
            for (int m = 0; m < 4; ++m) {
                const int row = row0 + ai * HALF + m * 16; const float rs = rs8[ai * 4 + m];
                float o[8];
#pragma unroll
                for (int n = 0; n < 2; ++n)
#pragma unroll
                    for (int j = 0; j < 4; ++j) { const float g = acc[ai][0][m][n][j] * rs, up = acc[ai][1][m][n][j] * rs; o[4 * n + j] = silu_f(g) * up; }
                *(u32x4*)(HID + (size_t)row * DFF + col0) = pack8(o);
            }
    }
};
struct EpiRes {
    static constexpr bool PERM = true;
    float* OUT; bf16_t* XB; float* rsp; float alpha;
    __device__ __forceinline__ void operator()(const f32x4 (&acc)[2][2][4][2], const Unit& u, int wr, int wc, int fr, int fq) const {
        const int row0 = u.pm * BM + wr * 64 + fr, col0 = u.pn * BM + wc * 32 + 8 * fq;
#pragma unroll
        for (int ai = 0; ai < 2; ++ai) {
            u32x4 xin[4][2];
#pragma unroll
            for (int m = 0; m < 4; ++m)
#pragma unroll
                for (int bj = 0; bj < 2; ++bj) xin[m][bj] = *(const u32x4*)(XB + (size_t)(row0 + ai * HALF + m * 16) * DM + col0 + bj * HALF);
#pragma unroll
            for (int m = 0; m < 4; ++m) {
                const int row = row0 + ai * HALF + m * 16; float ss = 0.f;
#pragma unroll
                for (int bj = 0; bj < 2; ++bj) {
                    const size_t off = (size_t)row * DM + col0 + bj * HALF;
                    float h[8]; unpack8(xin[m][bj], h);
#pragma unroll
                    for (int n = 0; n < 2; ++n)
#pragma unroll
                        for (int j = 0; j < 4; ++j) { h[4 * n + j] += acc[ai][bj][m][n][j] * alpha; ss += h[4 * n + j] * h[4 * n + j]; }
                    if (OUT != nullptr) { *(f32x4*)(OUT + off) = (f32x4){h[0], h[1], h[2], h[3]}; *(f32x4*)(OUT + off + 4) = (f32x4){h[4], h[5], h[6], h[7]}; }
                    else *(u32x4*)(XB + off) = pack8(h);
                }
                ss += __shfl_xor(ss, 16); ss += __shfl_xor(ss, 32);
                if (fq == 0) rsp[(size_t)row * 16 + u.pn * 4 + wc] = ss;
            }
        }
    }
};
struct EpiProj {
    static constexpr bool PERM = true;
    bf16_t* O; int pitch, coloff; const float* rsp; unsigned gelu_mask; float* DT; int dt_pn;
    __device__ __forceinline__ void operator()(const f32x4 (&acc)[2][2][4][2], const Unit& u, int wr, int wc, int fr, int fq) const {
        const int row0 = u.pm * BM + wr * 64 + fr, col0 = u.pn * BM + wc * 32 + 8 * fq;
        const bool ge = (gelu_mask >> u.pn) & 1u; const bool dtw = (DT != nullptr) && (u.pn == dt_pn) && (wc == 0) && (fq < 2);
        float rs8[8]; row_rs8(rsp, row0, fq, rs8);
#pragma unroll
        for (int ai = 0; ai < 2; ++ai)
#pragma unroll
            for (int m = 0; m < 4; ++m) {
                const int row = row0 + ai * HALF + m * 16; const float rs = rs8[ai * 4 + m];
#pragma unroll
                for (int bj = 0; bj < 2; ++bj) {
                    float o[8];
#pragma unroll
                    for (int n = 0; n < 2; ++n)
#pragma unroll
                        for (int j = 0; j < 4; ++j) { float v = acc[ai][bj][m][n][j] * rs; if (ge) v = gelu_tanh(v); o[4 * n + j] = v; }
                    *(u32x4*)(O + (size_t)row * pitch + coloff + col0 + bj * HALF) = pack8(o);
                    if (bj == 0 && dtw) { *(f32x4*)(DT + (size_t)row * 16 + 8 * fq) = (f32x4){o[0], o[1], o[2], o[3]}; *(f32x4*)(DT + (size_t)row * 16 + 8 * fq + 4) = (f32x4){o[4], o[5], o[6], o[7]}; }
                }
            }
    }
};

template <class Epi>
__device__ __forceinline__ void gemm_phase(LAS unsigned char* lds, const Gemm g, const StaticOrder& S, const Epi& E, const int tid) {
    const int wid = __builtin_amdgcn_readfirstlane(tid >> 6), lane = tid & 63, wr = wid >> 2, wc = wid & 3, fr = lane & 15, fq = lane >> 4;
    const int K = g.K, nt = K / BK, lda = g.lda;
    unsigned voffA[2], voffB[2];
#pragma unroll
    for (int i = 0; i < 2; ++i) { int R, C; stage_rc(tid * 16 + i * 8192, R, C); const int Rb = Epi::PERM ? ((R & ~31) + perm32(R & 31)) : R;
        voffA[i] = (unsigned)(R * lda + C) * 2u; voffB[i] = (unsigned)(Rb * K + C) * 2u; }
    const size_t kstep = (size_t)(BK * 2);
    const size_t hstepA = (size_t)HALF * lda * 2, hstepB = (size_t)HALF * K * 2;
    const size_t tstepA = 2 * hstepA, tstepB = 2 * hstepB;
    const unsigned ldsw = (unsigned)wid * 1024u;
    const int aoff = lds_byte(wr * 64 + fr, fq * 8), boff = lds_byte(wc * 32 + fr, fq * 8);
#define PG8_SA(b, h) (((b) * 2 + (h)) * HTB)
#define PG8_SB(b, h) ((4 + (b) * 2 + (h)) * HTB)
#define PG8_STAGE(bufoff, gbase, voff) do { _Pragma("unroll") for (int _i = 0; _i < 2; ++_i) \
        __builtin_amdgcn_global_load_lds((const unsigned*)((const char*)(gbase) + (voff)[_i]), (LAS unsigned*)(lds + (bufoff) + ldsw + _i * 8192), 16, 0, 0); } while (0)
#define PG8_LDA(dst, b, h) do { _Pragma("unroll") for (int m = 0; m < 4; ++m) _Pragma("unroll") for (int k = 0; k < 2; ++k) dst[m][k] = *(const LAS bf16x8*)(lds + PG8_SA(b, h) + aoff + m * 2048 + k * 1024); } while (0)
#define PG8_LDB(dst, b, h) do { _Pragma("unroll") for (int n = 0; n < 2; ++n) _Pragma("unroll") for (int k = 0; k < 2; ++k) dst[n][k] = *(const LAS bf16x8*)(lds + PG8_SB(b, h) + boff + n * 2048 + k * 1024); } while (0)
#define PG8_MMA(ai, bj, At, Bt) do { __builtin_amdgcn_s_setprio(1); _Pragma("unroll") for (int m = 0; m < 4; ++m) _Pragma("unroll") for (int n = 0; n < 2; ++n) _Pragma("unroll") for (int k = 0; k < 2; ++k) \
        acc[ai][bj][m][n] = __builtin_amdgcn_mfma_f32_16x16x32_bf16(Bt[n][k], At[m][k], acc[ai][bj][m][n], 0, 0, 0); __builtin_amdgcn_s_setprio(0); } while (0)
#define PG8_WAIT_V(n) asm volatile("s_waitcnt vmcnt(" #n ")" ::: "memory")
#define PG8_WAIT_L(n) asm volatile("s_waitcnt lgkmcnt(" #n ")" ::: "memory")
#define PG8_BAR __builtin_amdgcn_s_barrier()
#define PG8_SCHED __builtin_amdgcn_sched_barrier(0)
    Unit cur, nxt; int ui = 0;
    if (!S.next(0, cur)) return;
    f32x4 acc[2][2][4][2];
#pragma unroll
    for (int a = 0; a < 2; ++a)
#pragma unroll
        for (int b = 0; b < 2; ++b)
#pragma unroll
            for (int m = 0; m < 4; ++m)
#pragma unroll
                for (int n = 0; n < 2; ++n) acc[a][b][m][n] = (f32x4){0.f, 0.f, 0.f, 0.f};
    bf16x8 At[4][2], B0[2][2], B1[2][2];
    const char* cA = (const char*)g.A + (size_t)cur.pm * tstepA; const char* cB = (const char*)g.Bt + (size_t)cur.pn * tstepB;
    PG8_STAGE(PG8_SB(0, 0), cB, voffB); PG8_STAGE(PG8_SB(0, 1), cB + hstepB, voffB); PG8_STAGE(PG8_SA(0, 0), cA, voffA); PG8_STAGE(PG8_SA(0, 1), cA + hstepA, voffA);
    if (wr == 1) PG8_BAR;
    PG8_WAIT_V(2); PG8_BAR;
    PG8_STAGE(PG8_SB(1, 0), cB + kstep, voffB); PG8_STAGE(PG8_SA(1, 0), cA + kstep, voffA); PG8_STAGE(PG8_SB(1, 1), cB + hstepB + kstep, voffB);
    PG8_WAIT_V(6); PG8_BAR;
    for (;;) {
        const bool has_next = S.next(ui + 1, nxt);
        const char* nA = has_next ? (const char*)g.A + (size_t)nxt.pm * tstepA : cA; const char* nB = has_next ? (const char*)g.Bt + (size_t)nxt.pn * tstepB : cB;
        for (int t = 0; t < nt; t += 2) {
            const bool last = (t == nt - 2);
            const char* a1 = cA + (size_t)(t + 1) * kstep;
            const char* a2 = last ? nA : cA + (size_t)(t + 2) * kstep; const char* b2 = last ? nB : cB + (size_t)(t + 2) * kstep;
            const char* a3 = a2 + kstep; const char* b3 = b2 + kstep;
            PG8_LDB(B0, 0, 0); PG8_LDB(B1, 0, 1); PG8_SCHED; PG8_LDA(At, 0, 0); PG8_STAGE(PG8_SA(1, 1), a1 + hstepA, voffA);
            PG8_WAIT_V(8); PG8_WAIT_L(0); PG8_BAR; PG8_MMA(0, 0, At, B0); PG8_MMA(0, 1, At, B1); PG8_BAR; PG8_SCHED;
            PG8_LDA(At, 0, 1); PG8_STAGE(PG8_SB(0, 0), b2, voffB); PG8_STAGE(PG8_SB(0, 1), b2 + hstepB, voffB); PG8_STAGE(PG8_SA(0, 0), a2, voffA);
            PG8_WAIT_V(8); PG8_WAIT_L(0); PG8_BAR; PG8_MMA(1, 0, At, B0); PG8_MMA(1, 1, At, B1); PG8_BAR; PG8_SCHED;
            PG8_LDB(B0, 1, 0); PG8_LDB(B1, 1, 1); PG8_SCHED; PG8_LDA(At, 1, 0); PG8_STAGE(PG8_SA(0, 1), a2 + hstepA, voffA);
            PG8_WAIT_V(8); PG8_WAIT_L(0); PG8_BAR; PG8_MMA(0, 0, At, B0); PG8_MMA(0, 1, At, B1); PG8_BAR; PG8_SCHED;
            PG8_LDA(At, 1, 1); PG8_STAGE(PG8_SB(1, 0), b3, voffB); PG8_STAGE(PG8_SB(1, 1), b3 + hstepB, voffB); PG8_STAGE(PG8_SA(1, 0), a3, voffA);
            PG8_WAIT_V(8); PG8_WAIT_L(0); PG8_BAR; PG8_MMA(1, 0, At, B0); PG8_MMA(1, 1, At, B1); PG8_BAR; PG8_SCHED;
        }
        if (wr == 0) PG8_BAR;
        E(acc, cur, wr, wc, fr, fq);
        if (!has_next) break;
#pragma unroll
        for (int a = 0; a < 2; ++a)
#pragma unroll
            for (int b = 0; b < 2; ++b)
#pragma unroll
                for (int m = 0; m < 4; ++m)
#pragma unroll
                    for (int n = 0; n < 2; ++n) acc[a][b][m][n] = (f32x4){0.f, 0.f, 0.f, 0.f};
        cur = nxt; cA = nA; cB = nB; ++ui;
        if (wr == 1) PG8_BAR;
    }
    PG8_WAIT_V(0);
    PG8_BAR;
#undef PG8_SA
#undef PG8_SB
#undef PG8_STAGE
#undef PG8_LDA
#undef PG8_LDB
#undef PG8_MMA
#undef PG8_WAIT_V
#undef PG8_WAIT_L
#undef PG8_BAR
#undef PG8_SCHED
}
}

struct Args { const float* in[34]; float* out; unsigned char* ws; int ph_lo, ph_hi; };
enum { I_XP = 0, I_XS, I_SSM, I_CONV, I_POOL, I_CK, I_CV, I_F1N, I_F1GU, I_F1DN, I_MIXN, I_F2N, I_F2GU, I_F2DN, I_EWIN, I_EWOUT, I_ALNG, I_ALNB, I_AWS, I_ABS,
       I_CONVW, I_CONVB, I_DTB, I_ALOG, I_DSKIP, I_BNG, I_OWIN, I_OWOUT, I_CLIN, I_CSCALE, I_QN, I_KN, I_SINKS, I_REL };

constexpr int TAB_OFF = LDS_BYTES - 512;
struct InView { const LAS unsigned long long* t; __device__ __forceinline__ const float* operator[](int i) const { return (const float*)(GAS const float*)t[i]; } };
struct ArgsView { InView in; };
struct Ctx {
    LAS unsigned char* lds; int tid, lane, wave, fr, fq;
    const LAS unsigned long long* tab; float* out; unsigned char* ws; int dry;
    bf16_t* XB; float* RSP; float* DT; float* CDEC; bf16_t* BIG;
};

__device__ __forceinline__ Ctx relaunder(const Ctx& c) { Ctx d = c; int l; asm volatile("v_mbcnt_lo_u32_b32 %0, -1, 0\n\tv_mbcnt_hi_u32_b32 %0, -1, %0" : "=v"(l)); d.lane = l; d.tid = c.wave * 64 + l; d.fr = l & 15; d.fq = l >> 4; return d; }

__device__ __forceinline__ Ctx fresh_lane(const Ctx& c) { Ctx d = c; int l; asm volatile("v_mbcnt_lo_u32_b32 %0, -1, 0\n\tv_mbcnt_hi_u32_b32 %0, -1, %0" : "=v"(l)); d.lane = l; d.tid = c.wave * 64 + l; d.fr = l & 15; d.fq = l >> 4; return d; }

struct WJob { const float* W; bf16_t* WT; const float* gain; int K, Nsrc, Ndst, mode, gk_lo, gk_hi; };
__device__ __forceinline__ int srccol(int mode, int n) {
    if (mode == 0) return n;
    if (mode == 1) { const int t = n >> 8, r = n & 255; return r < 128 ? 128 * t + r : DFF + 128 * t + (r - 128); }
    if (mode == 2) { if (n < 1024) return n; if (n < 2048) return n + 1024; if (n < 3072) return n - 1024; if (n < 4624) return n; return -1; }
    return n < 1536 ? n + 1024 : n - 1536;
}
__device__ __forceinline__ void transpose_item(const WJob& J, LAS float* scr, int item, int lane) {
    const int nblk = J.Ndst / 32, kb = item / nblk, nb = item % nblk, k0 = 64 * kb, n0 = 32 * nb;
    const int nq = lane & 7, kr = lane >> 3; const int sc = srccol(J.mode, n0 + 4 * nq);
#pragma unroll
    for (int i = 0; i < 8; ++i) { const int kk = 8 * i + kr; const int k = k0 + kk;
        f32x4 v = sc >= 0 ? __builtin_nontemporal_load((const f32x4*)(J.W + (size_t)k * J.Nsrc + sc)) : (f32x4){0.f, 0.f, 0.f, 0.f};
        if (J.gain != nullptr && k >= J.gk_lo && k < J.gk_hi) v = v * J.gain[k - J.gk_lo];
        scr[kk * 33 + 4 * nq] = v[0]; scr[kk * 33 + 4 * nq + 1] = v[1]; scr[kk * 33 + 4 * nq + 2] = v[2]; scr[kk * 33 + 4 * nq + 3] = v[3]; }
    asm volatile("s_waitcnt lgkmcnt(0)" ::: "memory");
    const int c = lane & 7;
#pragma unroll
    for (int j = 0; j < 4; ++j) { const int n = (lane >> 3) + 8 * j; const LAS float* s = scr + (8 * c) * 33 + n;
        u32x4 o; o.x = pk2(s[0 * 33], s[1 * 33]); o.y = pk2(s[2 * 33], s[3 * 33]); o.z = pk2(s[4 * 33], s[5 * 33]); o.w = pk2(s[6 * 33], s[7 * 33]);
        *(u32x4*)(J.WT + (size_t)(n0 + n) * J.K + k0 + 8 * c) = o; }
    asm volatile("s_waitcnt lgkmcnt(0)" ::: "memory");
}
constexpr int NJOBS = 16;
__device__ __forceinline__ WJob make_job(const Ctx& c, int j) {
    const ArgsView a{{c.tab}}; WJob J; J.gain = nullptr; J.gk_lo = 0; J.gk_hi = 0; J.mode = 0;
    if (j < 8) {
        const int layer = j >> 2, f = (j >> 1) & 1, dn = j & 1;
        if (!dn) { J.W = (f ? a.in[I_F2GU] : a.in[I_F1GU]) + (size_t)layer * 1024 * 5632; J.WT = (bf16_t*)(c.ws + WS_WGU + (size_t)(layer * 2 + f) * SZ_WGU);
            J.K = 1024; J.Nsrc = 5632; J.Ndst = 5632; J.mode = 1; J.gain = (f ? a.in[I_F2N] : a.in[I_F1N]) + layer * 1024; J.gk_lo = 0; J.gk_hi = 1024; }
        else { J.W = (f ? a.in[I_F2DN] : a.in[I_F1DN]) + (size_t)layer * 2816 * 1024; J.WT = (bf16_t*)(c.ws + WS_WDN + (size_t)(layer * 2 + f) * SZ_WDN);
            J.K = 2816; J.Nsrc = 1024; J.Ndst = 1024; }
    } else if (j == 8) { J.W = a.in[I_EWIN]; J.WT = (bf16_t*)(c.ws + WS_WINE); J.K = 1024; J.Nsrc = 4624; J.Ndst = EV_N; J.mode = 2; J.gain = a.in[I_MIXN]; J.gk_hi = 1024; }
    else if (j == 9) { J.W = a.in[I_EWOUT]; J.WT = (bf16_t*)(c.ws + WS_WOUTE); J.K = 2048; J.Nsrc = 1024; J.Ndst = 1024; J.gain = a.in[I_BNG]; J.gk_lo = 1024; J.gk_hi = 2048; }
    else if (j == 10) { J.W = a.in[I_OWIN]; J.WT = (bf16_t*)(c.ws + WS_WINO); J.K = 1024; J.Nsrc = 2560; J.Ndst = OD_N; J.mode = 3; J.gain = a.in[I_MIXN] + 1024; J.gk_hi = 1024; }
    else if (j == 11) { J.W = a.in[I_OWOUT]; J.WT = (bf16_t*)(c.ws + WS_WOUTO); J.K = 2048; J.Nsrc = 1024; J.Ndst = 1024; J.gain = a.in[I_CSCALE]; J.gk_lo = 0; J.gk_hi = 1024; }
    else { const int gi = j - 12; J.W = a.in[I_CLIN] + (size_t)gi * 65536; J.WT = (bf16_t*)(c.ws + WS_CLIN) + (size_t)gi * 65536; J.K = 256; J.Nsrc = 256; J.Ndst = 256; }
    return J;
}
__device__ __forceinline__ int job_items(int j) {
    if (j < 8) return (j & 1) ? (2816 / 64) * (1024 / 32) : (1024 / 64) * (5632 / 32);
    if (j == 8) return (1024 / 64) * (EV_N / 32);
    if (j == 9 || j == 11) return (2048 / 64) * (1024 / 32);
    if (j == 10) return (1024 / 64) * (OD_N / 32);
    return (256 / 64) * (256 / 32);
}
__device__ __forceinline__ void convert_jobs(const Ctx& c, unsigned mask, int wgi, int nwg) {
    LAS float* scr = (LAS float*)(c.lds + c.wave * 16384);
    const int gw = wgi * NWAVES + c.wave, NGW = nwg * NWAVES;
    int base = 0;
    for (int j = 0; j < NJOBS; ++j) {
        if (!((mask >> j) & 1u)) continue;
        const int ni = job_items(j);
        int it = gw - (base % NGW); if (it < 0) it += NGW;
        if (it < ni) { const WJob J = make_job(c, j); for (; it < ni; it += NGW) transpose_item(J, scr, it, c.lane); }
        base += ni;
    }
}
constexpr unsigned JOBS_PRO = 1u << 0;
constexpr unsigned JOBS_GU_L0F1 = (1u << 1) | (1u << 8) | (1u << 9);
constexpr unsigned JOBS_PROJ_L0 = (1u << 2);
constexpr unsigned JOBS_GU_L0F2 = (1u << 3) | (1u << 4);
constexpr unsigned JOBS_GU_L1F1 = (1u << 10) | (0xFu << 12) | (1u << 5);
constexpr unsigned JOBS_PROJ_L1 = (1u << 11) | (1u << 6) | (1u << 7);
__device__ __forceinline__ void phase_prologue(const Ctx& c, int G) {
    convert_jobs(c, JOBS_PRO, (int)blockIdx.x, G);
    const int gw = blockIdx.x * NWAVES + c.wave, NGW = G * NWAVES;
    { const ArgsView a2{{c.tab}}; const float* wsp = a2.in[I_AWS]; unsigned* wmb = (unsigned*)(c.ws + WS_WMB); float* rsw = (float*)(c.ws + WS_RSW);
      for (int r = gw; r < 1024; r += NGW) { const int i = r & 127; const f32x2 w = *(const f32x2*)(wsp + (size_t)r * 128 + 2 * c.lane);
          const float w0 = (2 * c.lane <= i) ? w[0] : 0.f, w1 = (2 * c.lane + 1 <= i) ? w[1] : 0.f;
          wmb[(size_t)r * 64 + c.lane] = pk2(w0, w1); const float sm = wave_sum(w0 + w1); if (c.lane == 0) rsw[r] = sm; } }
    const ArgsView a{{c.tab}}; const float* xp = a.in[I_XP]; const float* xs = a.in[I_XS];
    for (int m = gw; m < MT; m += NGW) {
        const f32x4* src = (const f32x4*)(m < MP ? xp + (size_t)m * DM : xs + (size_t)(m - MP) * DM) + c.lane;
        f32x4 v[4]; float s = 0.f;
#pragma unroll
        for (int j = 0; j < 4; ++j) { v[j] = __builtin_nontemporal_load(src + 64 * j); s += (v[j][0] * v[j][0] + v[j][1] * v[j][1]) + (v[j][2] * v[j][2] + v[j][3] * v[j][3]); }
        s = wave_sum(s);
        u32x2* xo = (u32x2*)(c.XB + (size_t)m * DM) + c.lane;
#pragma unroll
        for (int j = 0; j < 4; ++j) { u32x2 w; w.x = pk2(v[j][0], v[j][1]); w.y = pk2(v[j][2], v[j][3]); xo[64 * j] = w; }
        if (c.lane < 16) c.RSP[(size_t)m * 16 + c.lane] = c.lane == 0 ? s : 0.f;
    }
}

__device__ __forceinline__ void gmlp_unit(const Ctx& c, int unit) {
    const ArgsView a{{c.tab}}; bf16_t* P = c.BIG; const size_t R0 = (size_t)unit * 128;
    LAS f32x2* PART = (LAS f32x2*)c.lds; LAS float* RS = (LAS float*)(c.lds + 4096); LAS float* LNG = (LAS float*)(c.lds + 4608); LAS float* LNB = (LAS float*)(c.lds + 8704);
    LAS bf16_t* Vt = (LAS bf16_t*)(c.lds + 12800); LAS bf16_t* Wm = (LAS bf16_t*)(c.lds + 12800 + 34816);
    const bf16_t* wmb = (const bf16_t*)(c.ws + WS_WMB); const float* rsw = (const float*)(c.ws + WS_RSW); const float* bs = a.in[I_ABS];
    const int j = c.tid & 127, eb = c.tid >> 7, wi = c.tid >> 2, wjs = (c.tid & 3) * 32;
    u32x4 vr[8][4];
#pragma unroll
    for (int h = 0; h < 8; ++h)
#pragma unroll
        for (int q = 0; q < 4; ++q) vr[h][q] = *(const u32x4*)(P + (R0 + j) * EV_PITCH + 2048 + h * 128 + eb * 32 + 8 * q);
    u32x4 wreg[4];
#pragma unroll
    for (int q = 0; q < 4; ++q) wreg[q] = *(const u32x4*)(wmb + (size_t)wi * 128 + wjs + 8 * q);
    { const f32x2 g2 = *(const f32x2*)(a.in[I_ALNG] + 2 * c.tid), b2 = *(const f32x2*)(a.in[I_ALNB] + 2 * c.tid);
      *(LAS f32x2*)(LNG + 2 * c.tid) = g2; *(LAS f32x2*)(LNB + 2 * c.tid) = b2; }
    { float sm = 0.f, sq = 0.f;
#pragma unroll
      for (int h = 0; h < 8; ++h)
#pragma unroll
          for (int q = 0; q < 4; ++q) { float x[8]; unpack8(vr[h][q], x);
#pragma unroll
              for (int e = 0; e < 8; ++e) { sm += x[e]; sq += x[e] * x[e]; } }
      PART[eb * 128 + j] = (f32x2){sm, sq}; }
    __syncthreads();
    float mean, rstd;
    { const f32x2 p0 = PART[j], p1 = PART[128 + j], p2 = PART[256 + j], p3 = PART[384 + j];
      mean = ((p0[0] + p1[0]) + (p2[0] + p3[0])) * (1.f / 1024.f);
      const float var = fmaxf(((p0[1] + p1[1]) + (p2[1] + p3[1])) * (1.f / 1024.f) - mean * mean, 0.f); rstd = rsqrtf(var + EPS); }
#pragma unroll 1
    for (int h = 0; h < 8; ++h) {
        bf16_t* up = P + (R0 + c.wave * 16 + c.fr) * EV_PITCH + h * 128 + 4 * c.fq; u32x2 uw8[8];
#pragma unroll
        for (int t = 0; t < 8; ++t) uw8[t] = *(const u32x2*)(up + 16 * t);
#pragma unroll
        for (int q = 0; q < 4; ++q) { float x[8]; unpack8(vr[0][q], x);
#pragma unroll
            for (int e = 0; e < 8; ++e) Vt[(eb * 32 + 8 * q + e) * 136 + j] = (bf16_t)f2bf((x[e] - mean) * rstd); }
#pragma unroll
        for (int hh = 0; hh < 7; ++hh)
#pragma unroll
            for (int q = 0; q < 4; ++q) vr[hh][q] = vr[hh + 1][q];
#pragma unroll
        for (int q = 0; q < 4; ++q) *(LAS u32x4*)(Wm + wi * 136 + wjs + 8 * q) = wreg[q];
        const float rsi = rsw[h * 128 + c.wave * 16 + c.fr];
        if (h < 7) {
#pragma unroll
            for (int q = 0; q < 4; ++q) wreg[q] = *(const u32x4*)(wmb + (size_t)(h + 1) * 16384 + (size_t)wi * 128 + wjs + 8 * q); }
        __syncthreads();
        f32x4 acc[8];
#pragma unroll
        for (int t = 0; t < 8; ++t) acc[t] = (f32x4){0.f, 0.f, 0.f, 0.f};
        const int kmax = (c.wave >> 1) + 1;
#pragma unroll 1
        for (int k = 0; k < kmax; ++k) { const bf16x8 af = LDS_BF8(Wm + (c.wave * 16 + c.fr) * 136 + k * 32 + c.fq * 8);
#pragma unroll
            for (int t = 0; t < 8; ++t) acc[t] = mfma16(LDS_BF8(Vt + (16 * t + c.fr) * 136 + k * 32 + c.fq * 8), af, acc[t]); }
        { const int i = c.wave * 16 + c.fr; const float bi = bs[h * 128 + i];
#pragma unroll
          for (int t = 0; t < 8; ++t) { const u32x2 uw = uw8[t]; const int e0 = h * 128 + 16 * t + 4 * c.fq;
              const f32x4 gg = *(const LAS f32x4*)(LNG + e0), bb = *(const LAS f32x4*)(LNB + e0);
              const f32x4 gt = gg * acc[t] + bb * rsi + bi; u32x2 o;
              o.x = pk2(bflo(uw.x) * gt[0], bfhi(uw.x) * gt[1]); o.y = pk2(bflo(uw.y) * gt[2], bfhi(uw.y) * gt[3]);
              if (!c.dry) *(u32x2*)(up + 16 * t) = o; } }
        __syncthreads();
    }
}
__device__ __forceinline__ void gmlp_sample_unit(const Ctx& c, int b) {
    const ArgsView a{{c.tab}}; bf16_t* P = c.BIG; const size_t R = (size_t)MP + 4 * b; const int c0 = 2 * c.tid, h = c0 >> 7;
    LAS float* RED = (LAS float*)c.lds;
    float v[4][2];
#pragma unroll
    for (int i = 0; i < 4; ++i) { const unsigned w = *(const unsigned*)(P + (R + i) * EV_PITCH + 2048 + c0); v[i][0] = bflo(w); v[i][1] = bfhi(w); }
#pragma unroll
    for (int i = 0; i < 4; ++i) { const float s = wave_sum(v[i][0] + v[i][1]), q = wave_sum(v[i][0] * v[i][0] + v[i][1] * v[i][1]);
        if (c.lane == 0) { RED[c.wave * 8 + i] = s; RED[c.wave * 8 + 4 + i] = q; } }
    __syncthreads();
    float vn[4][2];
#pragma unroll
    for (int i = 0; i < 4; ++i) { float s = 0.f, q = 0.f;
#pragma unroll
        for (int w = 0; w < 8; ++w) { s += RED[w * 8 + i]; q += RED[w * 8 + 4 + i]; }
        const float mean = s * (1.f / 1024.f), rstd = rsqrtf(fmaxf(q * (1.f / 1024.f) - mean * mean, 0.f) + EPS);
#pragma unroll
        for (int e = 0; e < 2; ++e) vn[i][e] = (v[i][e] - mean) * rstd * a.in[I_ALNG][c0 + e] + a.in[I_ALNB][c0 + e];
        *(f32x2*)(c.out + O_AV + ((size_t)b * 4 + i) * 1024 + c0) = (f32x2){vn[i][0], vn[i][1]}; }
#pragma unroll
    for (int i = 0; i < 4; ++i) { float g0 = a.in[I_ABS][h * 128 + i], g1 = g0;
#pragma unroll
        for (int j = 0; j <= i; ++j) { const float w = a.in[I_AWS][(size_t)h * 16384 + i * 128 + j]; g0 += w * vn[j][0]; g1 += w * vn[j][1]; }
        unsigned* up = (unsigned*)(P + (R + i) * EV_PITCH + c0); const unsigned uw = *up; if (!c.dry) *up = pk2(bflo(uw) * g0, bfhi(uw) * g1); }
    __syncthreads();
}

__device__ __forceinline__ void conv8(const bf16_t* P, size_t row, int pos, int cc, const float* cw, const float* cb, float (&o)[8]) {
    { const f32x4 b0 = *(const f32x4*)(cb + cc), b1 = *(const f32x4*)(cb + cc + 4);
#pragma unroll
      for (int e = 0; e < 8; ++e) o[e] = e < 4 ? b0[e & 3] : b1[e & 3]; }
#pragma unroll
    for (int tap = 0; tap < 4; ++tap) {
        if (pos - 3 + tap >= 0) { float x[8]; unpack8(*(const u32x4*)(P + (row - 3 + tap) * EV_PITCH + 3072 + cc), x);
            const f32x4 w0 = *(const f32x4*)(cw + tap * 1536 + cc), w1 = *(const f32x4*)(cw + tap * 1536 + cc + 4);
#pragma unroll
            for (int e = 0; e < 8; ++e) o[e] += (e < 4 ? w0[e & 3] : w1[e & 3]) * x[e]; }
    }
#pragma unroll
    for (int e = 0; e < 8; ++e) o[e] = silu_f(o[e]);
}
__device__ __forceinline__ void conv_load(const bf16_t* P, size_t row, int pos, int cc, u32x4 (&raw)[4]) {
#pragma unroll
    for (int tap = 0; tap < 4; ++tap) raw[tap] = (pos - 3 + tap >= 0) ? *(const u32x4*)(P + (row - 3 + tap) * EV_PITCH + 3072 + cc) : (u32x4){0u, 0u, 0u, 0u};
}
__device__ __forceinline__ void conv_fin(const u32x4 (&raw)[4], int cc, const float* cw, const float* cb, float (&o)[8]) {
    { const f32x4 b0 = *(const f32x4*)(cb + cc), b1 = *(const f32x4*)(cb + cc + 4);
#pragma unroll
      for (int e = 0; e < 8; ++e) o[e] = e < 4 ? b0[e & 3] : b1[e & 3]; }
#pragma unroll
    for (int tap = 0; tap < 4; ++tap) { float x[8]; unpack8(raw[tap], x);
        const f32x4 w0 = *(const f32x4*)(cw + tap * 1536 + cc), w1 = *(const f32x4*)(cw + tap * 1536 + cc + 4);
#pragma unroll
        for (int e = 0; e < 8; ++e) o[e] += (e < 4 ? w0[e & 3] : w1[e & 3]) * x[e]; }
#pragma unroll
    for (int e = 0; e < 8; ++e) o[e] = silu_f(o[e]);
}
__device__ __forceinline__ float ssd_dt_acum(const Ctx& c, size_t R0, int g, LAS float* ACUM, LAS float* DTV) {
    const ArgsView a{{c.tab}}; const int h = 8 * g + c.wave; const float bias = a.in[I_DTB][h], A = -__expf(a.in[I_ALOG][h]); const int j0 = 2 * c.lane;
    const float d0 = softplus_f(c.DT[(R0 + j0) * 16 + h] + bias), d1 = softplus_f(c.DT[(R0 + j0 + 1) * 16 + h] + bias);
    const float a0 = d0 * A, a1 = d1 * A, s = a0 + a1; float inc = s;
#pragma unroll
    for (int o = 1; o < 64; o <<= 1) { const float t = __shfl_up(inc, o); if (c.lane >= o) inc += t; }
    const float excl = inc - s;
    ACUM[c.wave * 128 + j0] = excl + a0; ACUM[c.wave * 128 + j0 + 1] = inc; DTV[c.wave * 128 + j0] = d0; DTV[c.wave * 128 + j0 + 1] = d1;
    return inc;
}
__device__ __forceinline__ void ssd_s1_unit(const Ctx& c, int unit) {
    const ArgsView a{{c.tab}}; const bf16_t* P = c.BIG; const int g = unit & 1, bc = unit >> 1, pos0 = (bc & 31) * 128; const size_t R0 = (size_t)bc * 128;
    LAS float* ACUM = (LAS float*)c.lds; LAS float* DTV = (LAS float*)(c.lds + 4096);
    LAS bf16_t* Bt = (LAS bf16_t*)(c.lds + 8192); LAS bf16_t* XT = (LAS bf16_t*)(c.lds + 43008);
    const float* cw = a.in[I_CONVW]; const float* cb = a.in[I_CONVB];
    const float tot = ssd_dt_acum(c, R0, g, ACUM, DTV);
    if (c.lane == 63) c.CDEC[bc * 16 + 8 * g + c.wave] = __expf(tot);
    { const int j = c.tid & 127, nb = c.tid >> 7; u32x4 raw[4][4];
#pragma unroll
      for (int q = 0; q < 4; ++q) conv_load(P, R0 + j, pos0 + j, 1024 + 128 * g + nb * 32 + 8 * q, raw[q]);
#pragma unroll
      for (int q = 0; q < 4; ++q) { float o[8]; conv_fin(raw[q], 1024 + 128 * g + nb * 32 + 8 * q, cw, cb, o);
#pragma unroll
          for (int e = 0; e < 8; ++e) Bt[(nb * 32 + 8 * q + e) * 136 + j] = (bf16_t)f2bf(o[e]); } }
    __syncthreads();
    bf16_t* ST = (bf16_t*)c.out;
    bf16_t* XC = (bf16_t*)c.out + (size_t)33554432;
    for (int pass = 0; pass < 2; ++pass) {
        { const int j = c.tid & 127, hl = c.tid >> 7, h8 = pass * 4 + hl; const float w = DTV[h8 * 128 + j] * __expf(ACUM[h8 * 128 + 127] - ACUM[h8 * 128 + j]);
          u32x4 raw[8][4];
#pragma unroll
          for (int q = 0; q < 8; ++q) conv_load(P, R0 + j, pos0 + j, (8 * g + h8) * 64 + 8 * q, raw[q]);
#pragma unroll
          for (int q = 0; q < 8; ++q) { float o[8]; conv_fin(raw[q], (8 * g + h8) * 64 + 8 * q, cw, cb, o);
              *(u32x4*)(XC + (R0 + j) * 1024 + (8 * g + h8) * 64 + 8 * q) = pack8(o);
#pragma unroll
              for (int e = 0; e < 8; ++e) XT[(hl * 64 + 8 * q + e) * 136 + j] = (bf16_t)f2bf(o[e] * w); } }
        __syncthreads();
        { const int hl = c.wave >> 1, nh = c.wave & 1; f32x4 acc[4][4];
#pragma unroll
          for (int x = 0; x < 4; ++x)
#pragma unroll
              for (int y = 0; y < 4; ++y) acc[x][y] = (f32x4){0.f, 0.f, 0.f, 0.f};
#pragma unroll
          for (int k = 0; k < 4; ++k) { bf16x8 af[4];
#pragma unroll
              for (int tp = 0; tp < 4; ++tp) af[tp] = LDS_BF8(XT + (hl * 64 + 16 * tp + c.fr) * 136 + k * 32 + c.fq * 8);
#pragma unroll
              for (int tn = 0; tn < 4; ++tn) { const bf16x8 bf = LDS_BF8(Bt + (nh * 64 + 16 * tn + c.fr) * 136 + k * 32 + c.fq * 8);
#pragma unroll
                  for (int tp = 0; tp < 4; ++tp) acc[tp][tn] = mfma16(bf, af[tp], acc[tp][tn]); } }
          const int h = 8 * g + pass * 4 + hl; bf16_t* st = ST + ((size_t)bc * 16 + h) * 8192;
#pragma unroll
          for (int tp = 0; tp < 4; ++tp)
#pragma unroll
              for (int tn = 0; tn < 4; ++tn) { u32x2 o; o.x = pk2(acc[tp][tn][0], acc[tp][tn][1]); o.y = pk2(acc[tp][tn][2], acc[tp][tn][3]);
                  *(u32x2*)(st + (16 * tp + c.fr) * 128 + nh * 64 + 16 * tn + 4 * c.fq) = o; } }
        __syncthreads();
    }
}
__device__ __forceinline__ void ssd_scan_unit(const Ctx& c, int unit) {
    const int t = unit * 512 + c.tid, b = t >> 16, rem = t & 65535, h = rem >> 12;
    unsigned* st = (unsigned*)c.out + (size_t)b * 32 * 65536 + rem;
    float s0 = 0.f, s1 = 0.f;
#pragma unroll 8
    for (int ch = 0; ch < 32; ++ch) { const unsigned v = st[(size_t)ch * 65536]; const float dec = c.CDEC[(b * 32 + ch) * 16 + h];
        if (!c.dry) st[(size_t)ch * 65536] = pk2(s0, s1); s0 = s0 * dec + bflo(v); s1 = s1 * dec + bfhi(v); }
    if (!c.dry) *(f32x2*)(c.out + O_SSM_P + (size_t)b * 131072 + (size_t)rem * 2) = (f32x2){s0, s1};
}
__device__ __forceinline__ void ssd_s3_unit(const Ctx& c, int unit) {
    const ArgsView a{{c.tab}}; bf16_t* P = c.BIG; const int g = unit & 1, bc = unit >> 1, pos0 = (bc & 31) * 128; const size_t R0 = (size_t)bc * 128;
    LAS float* ACUM = (LAS float*)c.lds; LAS float* DTV = (LAS float*)(c.lds + 4096);
    LAS bf16_t* CM = (LAS bf16_t*)(c.lds + 8192); LAS bf16_t* BMm = (LAS bf16_t*)(c.lds + 43008);
    LAS bf16_t* XT = (LAS bf16_t*)(c.lds + 43008); LAS bf16_t* PREV = (LAS bf16_t*)(c.lds + 60416);
    LAS bf16_t* MSW = (LAS bf16_t*)(c.lds + 77824 + c.wave * 4352);
    const float* cw = a.in[I_CONVW]; const float* cb = a.in[I_CONVB]; const int w = c.wave;
    (void)ssd_dt_acum(c, R0, g, ACUM, DTV);
    { const int j = c.tid >> 2, ns = (c.tid & 3) * 32;
#pragma unroll
      for (int bc2 = 0; bc2 < 2; ++bc2) { u32x4 rb[4][4]; const int cc0 = (bc2 ? 1280 : 1024) + 128 * g + ns; LAS bf16_t* dst = bc2 ? CM : BMm;
#pragma unroll
          for (int q = 0; q < 4; ++q) conv_load(P, R0 + j, pos0 + j, cc0 + 8 * q, rb[q]);
#pragma unroll
          for (int q = 0; q < 4; ++q) { float o[8]; conv_fin(rb[q], cc0 + 8 * q, cw, cb, o); *(LAS u32x4*)(dst + j * 136 + ns + 8 * q) = pack8(o); } } }
    __syncthreads();
    f32x4 cbv[8];
#pragma unroll
    for (int t = 0; t < 8; ++t) cbv[t] = (f32x4){0.f, 0.f, 0.f, 0.f};
#pragma unroll
    for (int k = 0; k < 4; ++k) { const bf16x8 af = LDS_BF8(CM + (16 * w + c.fr) * 136 + k * 32 + c.fq * 8);
#pragma unroll
        for (int t = 0; t < 8; ++t) if (t <= w) cbv[t] = mfma16(LDS_BF8(BMm + (16 * t + c.fr) * 136 + k * 32 + c.fq * 8), af, cbv[t]); }
    __syncthreads();
    float ssq = 0.f;
    const bf16_t* ST = (const bf16_t*)c.out;
    const int xj = c.tid & 127, xpb = c.tid >> 7, pvp = c.tid >> 3, pvseg = (c.tid & 7) * 16;
    const bf16_t* XC = (const bf16_t*)c.out + (size_t)33554432;
    u32x4 raw[2], pv0, pv1; u32x2 zn[4];
    { const int h = 8 * g;
#pragma unroll
      for (int q = 0; q < 2; ++q) raw[q] = *(const u32x4*)(XC + (R0 + xj) * 1024 + h * 64 + xpb * 16 + 8 * q);
      const bf16_t* sp = ST + ((size_t)bc * 16 + h) * 8192 + pvp * 128 + pvseg; pv0 = *(const u32x4*)sp; pv1 = *(const u32x4*)(sp + 8);
      const bf16_t* zq = P + (R0 + 16 * w + c.fr) * EV_PITCH + 1024 + h * 64 + 4 * c.fq;
#pragma unroll
      for (int t = 0; t < 4; ++t) zn[t] = *(const u32x2*)(zq + 16 * t); }
    for (int h8 = 0; h8 < 8; ++h8) {
        const int h = 8 * g + h8; const float dsk = a.in[I_DSKIP][h];
        bf16_t* zp = P + (R0 + 16 * w + c.fr) * EV_PITCH + 1024 + h * 64 + 4 * c.fq;
#pragma unroll
        for (int q = 0; q < 2; ++q) { const u32x4 rv = raw[q];
            XT[(xpb * 16 + 8 * q + 0) * 136 + xj] = (bf16_t)(rv.x & 0xffffu); XT[(xpb * 16 + 8 * q + 1) * 136 + xj] = (bf16_t)(rv.x >> 16);
            XT[(xpb * 16 + 8 * q + 2) * 136 + xj] = (bf16_t)(rv.y & 0xffffu); XT[(xpb * 16 + 8 * q + 3) * 136 + xj] = (bf16_t)(rv.y >> 16);
            XT[(xpb * 16 + 8 * q + 4) * 136 + xj] = (bf16_t)(rv.z & 0xffffu); XT[(xpb * 16 + 8 * q + 5) * 136 + xj] = (bf16_t)(rv.z >> 16);
            XT[(xpb * 16 + 8 * q + 6) * 136 + xj] = (bf16_t)(rv.w & 0xffffu); XT[(xpb * 16 + 8 * q + 7) * 136 + xj] = (bf16_t)(rv.w >> 16); }
        *(LAS u32x4*)(PREV + pvp * 136 + pvseg) = pv0; *(LAS u32x4*)(PREV + pvp * 136 + pvseg + 8) = pv1;
        if (h8 < 7) { const int hn = h + 1;
#pragma unroll
            for (int q = 0; q < 2; ++q) raw[q] = *(const u32x4*)(XC + (R0 + xj) * 1024 + hn * 64 + xpb * 16 + 8 * q);
            const bf16_t* sp = ST + ((size_t)bc * 16 + hn) * 8192 + pvp * 128 + pvseg; pv0 = *(const u32x4*)sp; pv1 = *(const u32x4*)(sp + 8); }
        { const int i = 16 * w + c.fr; const float ai = ACUM[h8 * 128 + i];
#pragma unroll
          for (int t = 0; t < 8; ++t) { const int j0 = 16 * t + 4 * c.fq; float v[4] = {0.f, 0.f, 0.f, 0.f};
              if (t <= w) { const f32x4 aj = *(const LAS f32x4*)(ACUM + h8 * 128 + j0), dj = *(const LAS f32x4*)(DTV + h8 * 128 + j0);
#pragma unroll
                  for (int jj = 0; jj < 4; ++jj) if (j0 + jj <= i) v[jj] = cbv[t][jj] * __expf(ai - aj[jj]) * dj[jj]; }
              u32x2 o; o.x = pk2(v[0], v[1]); o.y = pk2(v[2], v[3]); *(LAS u32x2*)(MSW + c.fr * 136 + j0) = o; } }
        __syncthreads();
        f32x4 yd[4], yo[4];
#pragma unroll
        for (int t = 0; t < 4; ++t) { yd[t] = (f32x4){0.f, 0.f, 0.f, 0.f}; yo[t] = (f32x4){0.f, 0.f, 0.f, 0.f}; }
#pragma unroll
        for (int k = 0; k < 4; ++k) { const bf16x8 ac = LDS_BF8(CM + (16 * w + c.fr) * 136 + k * 32 + c.fq * 8);
#pragma unroll
            for (int t = 0; t < 4; ++t) yo[t] = mfma16(LDS_BF8(PREV + (16 * t + c.fr) * 136 + k * 32 + c.fq * 8), ac, yo[t]); }
        { const int kmax = (w >> 1) + 1;
#pragma unroll 1
          for (int k = 0; k < kmax; ++k) { const bf16x8 am = LDS_BF8(MSW + c.fr * 136 + k * 32 + c.fq * 8);
#pragma unroll
              for (int t = 0; t < 4; ++t) yd[t] = mfma16(LDS_BF8(XT + (16 * t + c.fr) * 136 + k * 32 + c.fq * 8), am, yd[t]); } }
        { const int i = 16 * w + c.fr; const float ei = __expf(ACUM[h8 * 128 + i]);
#pragma unroll
          for (int t = 0; t < 4; ++t) { const u32x2 zw_ = zn[t]; float y[4];
#pragma unroll
              for (int jj = 0; jj < 4; ++jj) { const int p = 16 * t + 4 * c.fq + jj; y[jj] = yd[t][jj] + ei * yo[t][jj] + dsk * bf2f(XT[p * 136 + i]); }
              y[0] *= silu_f(bflo(zw_.x)); y[1] *= silu_f(bfhi(zw_.x)); y[2] *= silu_f(bflo(zw_.y)); y[3] *= silu_f(bfhi(zw_.y));
              ssq += (y[0] * y[0] + y[1] * y[1]) + (y[2] * y[2] + y[3] * y[3]);
              u32x2 o; o.x = pk2(y[0], y[1]); o.y = pk2(y[2], y[3]); if (!c.dry) *(u32x2*)(zp + 16 * t) = o; } }
        if (h8 < 7) {
#pragma unroll
            for (int t = 0; t < 4; ++t) zn[t] = *(const u32x2*)(zp + 64 + 16 * t); }
        __syncthreads();
    }
    { float sq = ssq; sq += __shfl_xor(sq, 16); sq += __shfl_xor(sq, 32);
      const float r = rsqrtf(sq * (1.f / 512.f) + EPS); const int i = 16 * w + c.fr;
      bf16_t* zp = P + (R0 + i) * EV_PITCH + 1024 + 8 * g * 64 + 4 * c.fq;
#pragma unroll
      for (int q = 0; q < 32; ++q) { const u32x2 v = *(const u32x2*)(zp + 16 * q); u32x2 o; o.x = pk2(bflo(v.x) * r, bfhi(v.x) * r); o.y = pk2(bflo(v.y) * r, bfhi(v.y) * r);
          if (!c.dry) *(u32x2*)(zp + 16 * q) = o; } }
}
__device__ __forceinline__ void ssd_sample_unit(const Ctx& c, int unit) {
    const ArgsView a{{c.tab}}; bf16_t* P = c.BIG; const int b = unit >> 1, g = unit & 1; const size_t R = (size_t)MP + 4 * b;
    LAS float* XS = (LAS float*)c.lds; LAS float* BS = (LAS float*)(c.lds + 8192); LAS float* CS = (LAS float*)(c.lds + 10240);
    LAS float* DTs = (LAS float*)(c.lds + 12288); LAS float* ACs = (LAS float*)(c.lds + 12416); LAS float* SSQ = (LAS float*)(c.lds + 12544);
    const float* cw = a.in[I_CONVW]; const float* cb = a.in[I_CONVB]; const float* sc = a.in[I_CONV];
    for (int idx = c.tid; idx < 768; idx += 512) {
        int col, stride; LAS float* dst;
        if (idx < 512) { col = g * 512 + idx; dst = XS + idx; stride = 512; } else if (idx < 640) { col = 1024 + 128 * g + (idx - 512); dst = BS + (idx - 512); stride = 128; }
        else { col = 1280 + 128 * g + (idx - 640); dst = CS + (idx - 640); stride = 128; }
        float e[7];
#pragma unroll
        for (int r = 0; r < 3; ++r) e[r] = sc[((size_t)b * 3 + r) * 1536 + col];
#pragma unroll
        for (int i = 0; i < 4; ++i) e[3 + i] = bf2f(P[(R + i) * EV_PITCH + 3072 + col]);
#pragma unroll
        for (int i = 0; i < 4; ++i) { float o = cb[col];
#pragma unroll
            for (int tap = 0; tap < 4; ++tap) o += cw[tap * 1536 + col] * e[i + tap];
            dst[i * stride] = silu_f(o); }
    }
    if (g == 0) for (int idx = c.tid; idx < 3 * 1536; idx += 512) { const int r = idx / 1536, col = idx % 1536;
        c.out[O_CONV_S + ((size_t)b * 3 + r) * 1536 + col] = bf2f(P[(R + r + 1) * EV_PITCH + 3072 + col]); }
    if (c.tid < 8) { const int h = 8 * g + c.tid; const float bias = a.in[I_DTB][h], A = -__expf(a.in[I_ALOG][h]); float acc = 0.f;
#pragma unroll
        for (int i = 0; i < 4; ++i) { const float d = softplus_f(c.DT[(R + i) * 16 + h] + bias); acc += d * A; DTs[i * 8 + c.tid] = d; ACs[i * 8 + c.tid] = acc; } }
    __syncthreads();
    const int h = 8 * g + c.wave; const float dsk = a.in[I_DSKIP][h];
    float dt[4], ac[4];
#pragma unroll
    for (int i = 0; i < 4; ++i) { dt[i] = DTs[i * 8 + c.wave]; ac[i] = ACs[i * 8 + c.wave]; }
    float cbm[4][4];
    { const int n0 = 2 * c.lane; float Bv[4][2], Cv[4][2];
#pragma unroll
      for (int i = 0; i < 4; ++i) { Bv[i][0] = BS[i * 128 + n0]; Bv[i][1] = BS[i * 128 + n0 + 1]; Cv[i][0] = CS[i * 128 + n0]; Cv[i][1] = CS[i * 128 + n0 + 1]; }
#pragma unroll
      for (int i = 0; i < 4; ++i)
#pragma unroll
          for (int j = 0; j < 4; ++j) { if (j <= i) { const float v = wave_sum(Cv[i][0] * Bv[j][0] + Cv[i][1] * Bv[j][1]); cbm[i][j] = v * __expf(ac[i] - ac[j]) * dt[j]; } else cbm[i][j] = 0.f; } }
    const float e3 = __expf(ac[3]);
    const int p = c.lane; float xv[4], wx[4];
#pragma unroll
    for (int j = 0; j < 4; ++j) { xv[j] = XS[j * 512 + c.wave * 64 + p]; wx[j] = __expf(ac[3] - ac[j]) * dt[j] * xv[j]; }
    const float* s0p = a.in[I_SSM] + ((size_t)b * 16 + h) * 8192 + (size_t)p * 128; float* sout = c.out + O_SSM_S + ((size_t)b * 16 + h) * 8192 + (size_t)p * 128;
    float yo[4] = {0.f, 0.f, 0.f, 0.f};
#pragma unroll 1
    for (int blk = 0; blk < 4; ++blk) {
        f32x4 sv[8];
#pragma unroll
        for (int q = 0; q < 8; ++q) sv[q] = *(const f32x4*)(s0p + blk * 32 + 4 * q);
#pragma unroll
        for (int q = 0; q < 8; ++q) { const int n = blk * 32 + 4 * q; f32x4 ns = sv[q] * e3;
#pragma unroll
            for (int j = 0; j < 4; ++j) { const f32x4 bq = *(const LAS f32x4*)(BS + j * 128 + n), cq = *(const LAS f32x4*)(CS + j * 128 + n);
                ns = ns + bq * wx[j]; yo[j] += (cq[0] * sv[q][0] + cq[1] * sv[q][1]) + (cq[2] * sv[q][2] + cq[3] * sv[q][3]); }
            *(f32x4*)(sout + n) = ns; }
    }
    float ym[4];
#pragma unroll
    for (int i = 0; i < 4; ++i) { float y = __expf(ac[i]) * yo[i] + dsk * xv[i];
#pragma unroll
        for (int j = 0; j < 4; ++j) y += cbm[i][j] * xv[j];
        ym[i] = y; }
#pragma unroll
    for (int i = 0; i < 4; ++i) { const float z = bf2f(P[(R + i) * EV_PITCH + 1024 + h * 64 + c.lane]); ym[i] *= silu_f(z); const float ss = wave_sum(ym[i] * ym[i]); if (c.lane == 0) SSQ[c.wave * 4 + i] = ss; }
    __syncthreads();
#pragma unroll
    for (int i = 0; i < 4; ++i) { float tot = 0.f;
#pragma unroll
        for (int w = 0; w < 8; ++w) tot += SSQ[w * 4 + i];
        if (!c.dry) P[(R + i) * EV_PITCH + 1024 + h * 64 + c.lane] = (bf16_t)f2bf(ym[i] * rsqrtf(tot * (1.f / 512.f) + EPS)); }
    __syncthreads();
}

__device__ __forceinline__ void pool_unit(const Ctx& c, int unit) {
    const ArgsView a{{c.tab}}; bf16_t* P = c.BIG; const int gi = unit & 3, rt = unit >> 2, win = 2 << gi; const size_t T0 = (size_t)rt * 128;
    LAS bf16_t* RAW = (LAS bf16_t*)c.lds;
    LAS bf16_t* A = (LAS bf16_t*)(c.lds + 75520);
    const float* sp = a.in[I_POOL];
    const bf16_t* LW = (const bf16_t*)(c.ws + WS_CLIN) + (size_t)gi * 65536;
    if (rt < 256) {
        const int posb = (int)(T0 & 4095);
        u32x4 rv[9];
#pragma unroll
        for (int i = 0; i < 9; ++i) { const int idx = c.tid + 512 * i, rr = idx >> 5, cq = idx & 31; rv[i] = (u32x4){0u, 0u, 0u, 0u};
            if (idx < 143 * 32 && posb - 15 + rr >= 0) rv[i] = *(const u32x4*)(P + (T0 - 15 + rr) * OD_PITCH + OD_N + gi * 256 + cq * 8); }
#pragma unroll
        for (int i = 0; i < 9; ++i) { const int idx = c.tid + 512 * i, rr = idx >> 5, cq = idx & 31; if (idx < 143 * 32) *(LAS u32x4*)(RAW + rr * 264 + cq * 8) = rv[i]; }
        __syncthreads();
        const int cp = c.tid & 127, l0 = (c.tid >> 7) * 32; float s0 = 0.f, s1 = 0.f;
        for (int k = 1; k < win; ++k) { const unsigned w = *(const LAS unsigned*)(RAW + (15 + l0 - k) * 264 + 2 * cp); s0 += bflo(w); s1 += bfhi(w); }
#pragma unroll 4
        for (int l = l0; l < l0 + 32; ++l) { const unsigned w = *(const LAS unsigned*)(RAW + (15 + l) * 264 + 2 * cp); const float c0 = bflo(w), c1 = bfhi(w);
            s0 += c0; s1 += c1; const float ic = 1.f / (float)min(posb + l + 1, win);
            *(LAS unsigned*)(A + l * 264 + 2 * cp) = pk2(s0 * ic - c0, s1 * ic - c1);
            const unsigned o = *(const LAS unsigned*)(RAW + (15 + l - win + 1) * 264 + 2 * cp); s0 -= bflo(o); s1 -= bfhi(o); }
    } else {
        const float ic = 1.f / (float)win; const int b0 = (int)((T0 - MP) >> 2);
        for (int it = c.tid; it < 2048; it += 512) { const int bl = it >> 6, cq = it & 63, bb = b0 + bl; f32x4 ext[19];
#pragma unroll
            for (int e = 0; e < 15; ++e) ext[e] = *(const f32x4*)(sp + ((size_t)bb * 15 + e) * 1024 + gi * 256 + 4 * cq);
#pragma unroll
            for (int i = 0; i < 4; ++i) { const u32x2 w = *(const u32x2*)(P + ((size_t)MP + 4 * bb + i) * OD_PITCH + OD_N + gi * 256 + 4 * cq); ext[15 + i] = (f32x4){bflo(w.x), bfhi(w.x), bflo(w.y), bfhi(w.y)}; }
#pragma unroll
            for (int i = 0; i < 4; ++i) { f32x4 sm = (f32x4){0.f, 0.f, 0.f, 0.f};
#pragma unroll
                for (int k = 0; k < 16; ++k) if (k < win) sm = sm + ext[15 + i - k];
                const f32x4 o = sm * ic - ext[15 + i]; u32x2 w; w.x = pk2(o[0], o[1]); w.y = pk2(o[2], o[3]);
                *(LAS u32x2*)(A + (4 * bl + i) * 264 + 4 * cq) = w; } }
    }
    LAS bf16_t* Bs = RAW;
    u32x4 breg[8];
#pragma unroll
    for (int i = 0; i < 8; ++i) { const int idx = c.tid + 512 * i; breg[i] = *(const u32x4*)(LW + (size_t)(idx >> 5) * 256 + (idx & 31) * 8); }
    __syncthreads();
    for (int half = 0; half < 2; ++half) {
#pragma unroll
        for (int i = 0; i < 8; ++i) { const int idx = c.tid + 512 * i; *(LAS u32x4*)(Bs + (idx >> 5) * 264 + (idx & 31) * 8) = breg[i]; }
        if (half == 0) {
#pragma unroll
            for (int i = 0; i < 8; ++i) { const int idx = c.tid + 512 * i; breg[i] = *(const u32x4*)(LW + (size_t)(128 + (idx >> 5)) * 256 + (idx & 31) * 8); } }
        __syncthreads();
        f32x4 acc[8];
#pragma unroll
        for (int t = 0; t < 8; ++t) acc[t] = (f32x4){0.f, 0.f, 0.f, 0.f};
#pragma unroll
        for (int k = 0; k < 8; ++k) { const bf16x8 af = LDS_BF8(A + (16 * c.wave + c.fr) * 264 + k * 32 + c.fq * 8);
#pragma unroll
            for (int t = 0; t < 8; ++t) acc[t] = mfma16(LDS_BF8(Bs + (16 * t + c.fr) * 264 + k * 32 + c.fq * 8), af, acc[t]); }
        { bf16_t* op = P + (T0 + 16 * c.wave + c.fr) * OD_PITCH + gi * 256 + half * 128 + 4 * c.fq;
#pragma unroll
          for (int t = 0; t < 8; ++t) { u32x2 o; o.x = pk2(acc[t][0], acc[t][1]); o.y = pk2(acc[t][2], acc[t][3]); *(u32x2*)(op + 16 * t) = o; } }
        __syncthreads();
    }
}

template <int NST, int NKS, int VP, int PP, bool PRE>
__device__ __forceinline__ void attn_core(bf16x8 q0, bf16x8 q1, LAS const bf16_t* Ks, LAS const bf16_t* Vt, LAS const float* BIASl, LAS bf16_t* PS, int t0,
                                          int dbase, int gsel, float sink, int kmin, int kmax, int fr, int fq, f32x4 (&o)[4], const f32x4 (&bm)[NST]) {
    f32x4 s[NST];
#pragma unroll
    for (int t = 0; t < NST; ++t) { s[t] = (f32x4){0.f, 0.f, 0.f, 0.f};
        s[t] = mfma16(LDS_BF8(Ks + (16 * (t0 + t) + fr) * 72 + fq * 8), q0, s[t]); s[t] = mfma16(LDS_BF8(Ks + (16 * (t0 + t) + fr) * 72 + 32 + fq * 8), q1, s[t]); }
    float mx = sink;
#pragma unroll
    for (int t = 0; t < NST; ++t)
#pragma unroll
        for (int jj = 0; jj < 4; ++jj) { float v;
            if (PRE) { v = s[t][jj] + bm[t][jj]; if (16 * (t0 + t) + 4 * fq + jj < kmin) v = -1e30f; v = fmaxf(v, -1e30f); }
            else { const int kk = 16 * (t0 + t) + 4 * fq + jj, d = dbase - kk; const bool valid = d >= 0 && d < 128 && kk >= kmin && kk < kmax;
                v = valid ? s[t][jj] + BIASl[gsel * 128 + (d & 127)] : -1e30f; }
            s[t][jj] = v; mx = fmaxf(mx, v); }
    mx = fmaxf(mx, __shfl_xor(mx, 16)); mx = fmaxf(mx, __shfl_xor(mx, 32));
    float sum = 0.f;
#pragma unroll
    for (int t = 0; t < NST; ++t) { float p[4];
#pragma unroll
        for (int jj = 0; jj < 4; ++jj) { p[jj] = __expf(s[t][jj] - mx); sum += p[jj]; }
        u32x2 w; w.x = pk2(p[0], p[1]); w.y = pk2(p[2], p[3]); *(LAS u32x2*)(PS + fr * PP + 16 * t + 4 * fq) = w; }
#pragma unroll
    for (int t = NST; t < 2 * NKS; ++t) *(LAS u32x2*)(PS + fr * PP + 16 * t + 4 * fq) = (u32x2){0u, 0u};
    sum += __shfl_xor(sum, 16); sum += __shfl_xor(sum, 32);
    const float inv = 1.f / (sum + __expf(sink - mx));
#pragma unroll
    for (int td = 0; td < 4; ++td) o[td] = (f32x4){0.f, 0.f, 0.f, 0.f};
#pragma unroll
    for (int k = 0; k < NKS; ++k) { const bf16x8 pa = LDS_BF8(PS + fr * PP + k * 32 + fq * 8);
#pragma unroll
        for (int td = 0; td < 4; ++td) o[td] = mfma16(LDS_BF8(Vt + (16 * td + fr) * VP + 16 * t0 + k * 32 + fq * 8), pa, o[td]); }
#pragma unroll
    for (int td = 0; td < 4; ++td) o[td] = o[td] * inv;
}
__device__ __forceinline__ void load_q(const bf16_t* qp, const float* qn, int fq, bf16x8& q0, bf16x8& q1) {
    float x[8], y[8]; unpack8(*(const u32x4*)(qp + fq * 8), x); unpack8(*(const u32x4*)(qp + 32 + fq * 8), y);
    float ss = 0.f;
#pragma unroll
    for (int e = 0; e < 8; ++e) ss += x[e] * x[e] + y[e] * y[e];
    ss += __shfl_xor(ss, 16); ss += __shfl_xor(ss, 32);
    const float rs = rsqrtf(ss * (1.f / 64.f) + EPS) * 0.125f;
#pragma unroll
    for (int e = 0; e < 8; ++e) { x[e] *= rs * qn[fq * 8 + e]; y[e] *= rs * qn[32 + fq * 8 + e]; }
    const u32x4 a = pack8(x), b = pack8(y); q0 = __builtin_bit_cast(bf16x8, a); q1 = __builtin_bit_cast(bf16x8, b);
}
__device__ __forceinline__ void attn_prompt_unit(const Ctx& c, int unit) {
    const ArgsView a{{c.tab}}; bf16_t* P = c.BIG; const int hk = unit & 3, bb = unit >> 2, blk = bb & 31, b = bb >> 5; const size_t Q0 = (size_t)bb * 128;
    LAS bf16_t* Ks = (LAS bf16_t*)c.lds; LAS bf16_t* Vt = (LAS bf16_t*)(c.lds + 36864); LAS float* BIASl = (LAS float*)(c.lds + 72704);
    LAS bf16_t* PS = (LAS bf16_t*)(c.lds + 74752 + c.wave * 5376);
    if (c.tid < 64) { *(LAS u32x4*)(Vt + c.tid * 280 + 256) = (u32x4){0u, 0u, 0u, 0u}; *(LAS u32x4*)(Vt + c.tid * 280 + 264) = (u32x4){0u, 0u, 0u, 0u}; }
    { const int kk = c.tid >> 1, half = c.tid & 1; const bool ok = (blk > 0) || kk >= 128; float v[32];
      if (ok) { const bf16_t* kp = P + (Q0 - 128 + kk) * OD_PITCH + 2048 + hk * 64 + half * 32;
#pragma unroll
          for (int q = 0; q < 4; ++q) { float x[8]; unpack8(*(const u32x4*)(kp + 8 * q), x);
#pragma unroll
              for (int e = 0; e < 8; ++e) v[8 * q + e] = x[e]; } }
      else {
#pragma unroll
          for (int e = 0; e < 32; ++e) v[e] = 0.f; }
      float ss = 0.f;
#pragma unroll
      for (int e = 0; e < 32; ++e) ss += v[e] * v[e];
      ss += __shfl_xor(ss, 1); const float rs = rsqrtf(ss * (1.f / 64.f) + EPS);
#pragma unroll
      for (int e = 0; e < 32; ++e) v[e] *= rs * a.in[I_KN][half * 32 + e];
#pragma unroll
      for (int q = 0; q < 4; ++q) { float x[8];
#pragma unroll
          for (int e = 0; e < 8; ++e) x[e] = v[8 * q + e];
          *(LAS u32x4*)(Ks + kk * 72 + half * 32 + 8 * q) = pack8(x); }
      if (blk == 31 && kk >= 128) { float* op = c.out + O_K_P + (((size_t)b * 128 + (kk - 128)) * 4 + hk) * 64 + half * 32;
#pragma unroll
          for (int q = 0; q < 8; ++q) *(f32x4*)(op + 4 * q) = (f32x4){v[4 * q], v[4 * q + 1], v[4 * q + 2], v[4 * q + 3]}; } }
    { const int kk = c.tid & 255, dh = c.tid >> 8; const bool ok = (blk > 0) || kk >= 128; float v[32];
      if (ok) { const bf16_t* vp = P + (Q0 - 128 + kk) * OD_PITCH + 2304 + hk * 64 + dh * 32;
#pragma unroll
          for (int q = 0; q < 4; ++q) { float x[8]; unpack8(*(const u32x4*)(vp + 8 * q), x);
#pragma unroll
              for (int e = 0; e < 8; ++e) v[8 * q + e] = x[e]; } }
      else {
#pragma unroll
          for (int e = 0; e < 32; ++e) v[e] = 0.f; }
#pragma unroll
      for (int e = 0; e < 32; ++e) Vt[(dh * 32 + e) * 280 + kk] = (bf16_t)f2bf(v[e]);
      if (blk == 31 && kk >= 128) { float* op = c.out + O_V_P + (((size_t)b * 128 + (kk - 128)) * 4 + hk) * 64 + dh * 32;
#pragma unroll
          for (int q = 0; q < 8; ++q) *(f32x4*)(op + 4 * q) = (f32x4){v[4 * q], v[4 * q + 1], v[4 * q + 2], v[4 * q + 3]}; } }
    { const int g = c.tid >> 7, d = c.tid & 127; BIASl[c.tid] = a.in[I_REL][(int)T5B[d] * 16 + hk * 4 + g]; }
    __syncthreads();
    const int g = c.wave >> 1, hq = hk * 4 + g, half = c.wave & 1; const float sk = a.in[I_SINKS][hq];
    bf16x8 qa[4], qb[4];
#pragma unroll
    for (int r4 = 0; r4 < 4; ++r4) load_q(P + (Q0 + half * 64 + r4 * 16 + c.fr) * OD_PITCH + 1024 + hq * 64, a.in[I_QN], c.fq, qa[r4], qb[r4]);
    f32x4 bm[9];
#pragma unroll
    for (int t = 0; t < 9; ++t)
#pragma unroll
        for (int jj = 0; jj < 4; ++jj) { const int d = 128 + c.fr - 16 * t - 4 * c.fq - jj; bm[t][jj] = (d >= 0 && d < 128) ? BIASl[g * 128 + (d & 127)] : -2e30f; }
#pragma unroll
    for (int r4 = 0; r4 < 4; ++r4) {
        const int i0 = half * 64 + r4 * 16; const bf16x8 q0 = qa[r4], q1 = qb[r4];
        f32x4 o[4];
        attn_core<9, 5, 280, 168, true>(q0, q1, Ks, Vt, BIASl, PS, i0 >> 4, 128 + i0 + c.fr, g, sk, blk > 0 ? 0 : 128, 256, c.fr, c.fq, o, bm);
        { bf16_t* op = P + (Q0 + i0 + c.fr) * OD_PITCH + 1024 + hq * 64 + 4 * c.fq;
#pragma unroll
          for (int td = 0; td < 4; ++td) { u32x2 w; w.x = pk2(o[td][0], o[td][1]); w.y = pk2(o[td][2], o[td][3]); if (!c.dry) *(u32x2*)(op + 16 * td) = w; } }
    }
    __syncthreads();
}
__device__ __forceinline__ void attn_sample_unit(const Ctx& c, int unit) {
    const ArgsView a{{c.tab}}; bf16_t* P = c.BIG; const int hk = unit & 3, b = unit >> 2; const size_t R = (size_t)MP + 4 * b;
    LAS bf16_t* Ks = (LAS bf16_t*)c.lds; LAS bf16_t* Vt = (LAS bf16_t*)(c.lds + 23040); LAS float* BIASl = (LAS float*)(c.lds + 44544); LAS bf16_t* PS = (LAS bf16_t*)(c.lds + 46592);
    { const int kk = c.tid >> 1, half = c.tid & 1;
      if (kk < 160) { float v[32];
          if (kk < 128) { const float* kp = a.in[I_CK] + (((size_t)b * 128 + kk) * 4 + hk) * 64 + half * 32;
#pragma unroll
              for (int q = 0; q < 8; ++q) { const f32x4 x = *(const f32x4*)(kp + 4 * q); v[4 * q] = x[0]; v[4 * q + 1] = x[1]; v[4 * q + 2] = x[2]; v[4 * q + 3] = x[3]; } }
          else if (kk < 132) { const bf16_t* kp = P + (R + (kk - 128)) * OD_PITCH + 2048 + hk * 64 + half * 32;
#pragma unroll
              for (int q = 0; q < 4; ++q) { float x[8]; unpack8(*(const u32x4*)(kp + 8 * q), x);
#pragma unroll
                  for (int e = 0; e < 8; ++e) v[8 * q + e] = x[e]; } }
          else {
#pragma unroll
              for (int e = 0; e < 32; ++e) v[e] = 0.f; }
          float ss = 0.f;
#pragma unroll
          for (int e = 0; e < 32; ++e) ss += v[e] * v[e];
          ss += __shfl_xor(ss, 1);
          if (kk >= 128) { const float rs = rsqrtf(ss * (1.f / 64.f) + EPS);
#pragma unroll
              for (int e = 0; e < 32; ++e) v[e] *= rs * a.in[I_KN][half * 32 + e]; }
#pragma unroll
          for (int q = 0; q < 4; ++q) { float x[8];
#pragma unroll
              for (int e = 0; e < 8; ++e) x[e] = v[8 * q + e];
              *(LAS u32x4*)(Ks + kk * 72 + half * 32 + 8 * q) = pack8(x); }
          if (kk >= 4 && kk < 132) { float* op = c.out + O_K_S + (((size_t)b * 128 + (kk - 4)) * 4 + hk) * 64 + half * 32;
#pragma unroll
              for (int q = 0; q < 8; ++q) *(f32x4*)(op + 4 * q) = (f32x4){v[4 * q], v[4 * q + 1], v[4 * q + 2], v[4 * q + 3]}; } }
      else { (void)__shfl_xor(0.f, 1); } }
    { const int kk = c.tid & 255, dh = c.tid >> 8;
      if (kk < 160) { float v[32];
          if (kk < 128) { const float* vp = a.in[I_CV] + (((size_t)b * 128 + kk) * 4 + hk) * 64 + dh * 32;
#pragma unroll
              for (int q = 0; q < 8; ++q) { const f32x4 x = *(const f32x4*)(vp + 4 * q); v[4 * q] = x[0]; v[4 * q + 1] = x[1]; v[4 * q + 2] = x[2]; v[4 * q + 3] = x[3]; } }
          else if (kk < 132) { const bf16_t* vp = P + (R + (kk - 128)) * OD_PITCH + 2304 + hk * 64 + dh * 32;
#pragma unroll
              for (int q = 0; q < 4; ++q) { float x[8]; unpack8(*(const u32x4*)(vp + 8 * q), x);
#pragma unroll
                  for (int e = 0; e < 8; ++e) v[8 * q + e] = x[e]; } }
          else {
#pragma unroll
              for (int e = 0; e < 32; ++e) v[e] = 0.f; }
#pragma unroll
          for (int e = 0; e < 32; ++e) Vt[(dh * 32 + e) * 168 + kk] = (bf16_t)f2bf(v[e]);
          if (kk >= 4 && kk < 132) { float* op = c.out + O_V_S + (((size_t)b * 128 + (kk - 4)) * 4 + hk) * 64 + dh * 32;
#pragma unroll
              for (int q = 0; q < 8; ++q) *(f32x4*)(op + 4 * q) = (f32x4){v[4 * q], v[4 * q + 1], v[4 * q + 2], v[4 * q + 3]}; } } }
    { const int g = c.tid >> 7, d = c.tid & 127; BIASl[c.tid] = a.in[I_REL][(int)T5B[d] * 16 + hk * 4 + g]; }
    __syncthreads();
    if (c.wave == 0) {
        bf16x8 q0, q1; const int gq = c.fr >> 2, iq = c.fr & 3;
        load_q(P + (R + iq) * OD_PITCH + 1024 + (hk * 4 + gq) * 64, a.in[I_QN], c.fq, q0, q1);
        f32x4 o[4];
        f32x4 bm0[10]; attn_core<10, 5, 168, 168, false>(q0, q1, Ks, Vt, BIASl, PS, 0, 128 + iq, gq, a.in[I_SINKS][hk * 4 + gq], 0, 132, c.fr, c.fq, o, bm0);
        { bf16_t* op = P + (R + iq) * OD_PITCH + 1024 + (hk * 4 + gq) * 64 + 4 * c.fq;
#pragma unroll
          for (int td = 0; td < 4; ++td) { u32x2 w; w.x = pk2(o[td][0], o[td][1]); w.y = pk2(o[td][2], o[td][3]); if (!c.dry) *(u32x2*)(op + 16 * td) = w; } }
    }
    __syncthreads();
}

template <int KS>
__device__ __forceinline__ void mini_res_gemm(const Ctx& c, const bf16_t* A, int lda, const bf16_t* Bt, float alpha, int G, float* OUT) {
    constexpr int K = KS * 256;
    LAS float* PART = (LAS float*)c.lds;
    for (int it = blockIdx.x; it < 256; it += G) {
        const int r0 = (it >> 4) * 32, c0 = (it & 15) * 64;
        f32x4 acc[2][4];
#pragma unroll
        for (int mi = 0; mi < 2; ++mi)
#pragma unroll
            for (int ni = 0; ni < 4; ++ni) acc[mi][ni] = (f32x4){0.f, 0.f, 0.f, 0.f};
        const bf16_t* ap = A + (size_t)(r0 + c.fr) * lda + c.wave * (KS * 32) + c.fq * 8;
        const bf16_t* bp = Bt + (size_t)(c0 + c.fr) * K + c.wave * (KS * 32) + c.fq * 8;
#pragma unroll
        for (int ks = 0; ks < KS; ++ks) {
            bf16x8 af[2], bf[4];
#pragma unroll
            for (int mi = 0; mi < 2; ++mi) af[mi] = *(const bf16x8*)(ap + (size_t)mi * 16 * lda + ks * 32);
#pragma unroll
            for (int ni = 0; ni < 4; ++ni) bf[ni] = *(const bf16x8*)(bp + (size_t)ni * 16 * K + ks * 32);
#pragma unroll
            for (int mi = 0; mi < 2; ++mi)
#pragma unroll
                for (int ni = 0; ni < 4; ++ni) acc[mi][ni] = mfma16(af[mi], bf[ni], acc[mi][ni]);
        }
#pragma unroll
        for (int mi = 0; mi < 2; ++mi)
#pragma unroll
            for (int ni = 0; ni < 4; ++ni)
#pragma unroll
                for (int j = 0; j < 4; ++j) PART[c.wave * 2048 + (16 * mi + 4 * c.fq + j) * 64 + 16 * ni + c.fr] = acc[mi][ni][j];
        __syncthreads();
        { const int row = c.tid >> 4, cq = c.tid & 15; f32x4 v = (f32x4){0.f, 0.f, 0.f, 0.f};
#pragma unroll
          for (int w = 0; w < 8; ++w) v = v + *(const LAS f32x4*)(PART + w * 2048 + row * 64 + 4 * cq);
          const size_t grow = (size_t)MP + r0 + row; const size_t off = grow * DM + c0 + 4 * cq;
          const u32x2 xw = *(const u32x2*)(c.XB + off); f32x4 h = (f32x4){bflo(xw.x), bfhi(xw.x), bflo(xw.y), bfhi(xw.y)} + v * alpha;
          if (OUT != nullptr) *(f32x4*)(OUT + off) = h;
          else { u32x2 w2; w2.x = pk2(h[0], h[1]); w2.y = pk2(h[2], h[3]); *(u32x2*)(c.XB + off) = w2; }
          float ss = (h[0] * h[0] + h[1] * h[1]) + (h[2] * h[2] + h[3] * h[3]);
          ss += __shfl_xor(ss, 1); ss += __shfl_xor(ss, 2); ss += __shfl_xor(ss, 4); ss += __shfl_xor(ss, 8);
          if (cq == 0) c.RSP[grow * 16 + (it & 15)] = ss; }
        __syncthreads();
    }
}

#define XB_TMO      128
#define XB_XCNT(j)  (256  + 64 * (j))
#define XB_XSUB(j)  (1280 + 64 * (j))
#define XB_XGEN(j)  (2304 + 64 * (j))
#define XB_TOP      3328
#define XB_TOPGEN   3392
#define XCD_BAR_WORDS 3456
#define XB_SPIN_CAP (1u << 18)
__device__ __forceinline__ unsigned xb_ld(unsigned* p)              { return __hip_atomic_load(p, __ATOMIC_RELAXED, __HIP_MEMORY_SCOPE_AGENT); }
__device__ __forceinline__ unsigned xb_add(unsigned* p, unsigned v) { return __hip_atomic_fetch_add(p, v, __ATOMIC_RELAXED, __HIP_MEMORY_SCOPE_AGENT); }
__device__ __forceinline__ unsigned xb_xcc_id() { return (unsigned)__builtin_amdgcn_s_getreg((3 << 11) | 20) & 0xFu; }
#define XB_SPIN(cond, bar) do { unsigned _sp = 0; while (cond) { __builtin_amdgcn_s_sleep(1); \
    if ((++_sp & 255u) == 0u) { if (xb_ld(&(bar)[XB_TMO])) break; if (_sp > XB_SPIN_CAP) { atomicAdd(&(bar)[XB_TMO], 1u); break; } } } } while (0)
__device__ __forceinline__ void xcd_barrier_complete(unsigned* bar, unsigned x, unsigned& nloc, unsigned& nx) {
    const unsigned G = gridDim.x * gridDim.y * gridDim.z;
    unsigned sum, cnt, mine, sp = 0u;
    for (;;) {
        sum = 0u; cnt = 0u; mine = 0u;
#pragma unroll
        for (unsigned j = 0; j < 16; ++j) { const unsigned c = xb_ld(&bar[XB_XCNT(j)]); sum += c; cnt += (c > 0u) ? 1u : 0u; mine = (j == x) ? c : mine; }
        if (sum == G) break;
        __builtin_amdgcn_s_sleep(1);
        if ((++sp & 255u) == 0u) { if (xb_ld(&bar[XB_TMO])) break; if (sp > XB_SPIN_CAP) { atomicAdd(&bar[XB_TMO], 1u); break; } }
    }
    nloc = mine > 0u ? mine : 1u; nx = cnt > 0u ? cnt : 1u;
}
__device__ __forceinline__ void xcd_barrier(unsigned* bar, volatile LAS unsigned* st, bool leader) {
    asm volatile("s_waitcnt vmcnt(0)" ::: "memory");
    __syncthreads();
    if (leader) {
        const unsigned x = xb_xcc_id();
        __builtin_amdgcn_s_waitcnt(0);
        unsigned nloc = st[0], nx = st[1];
        if (nloc == 0u) { xcd_barrier_complete(bar, x, nloc, nx); st[0] = nloc; st[1] = nx; }
        const unsigned old = xb_add(&bar[XB_XSUB(x)], 1u);
        const unsigned gen = old / nloc;
        if (old + 1u == (gen + 1u) * nloc) {
            __builtin_amdgcn_fence(__ATOMIC_RELEASE, "agent");
            asm volatile("s_waitcnt vmcnt(0)" ::: "memory");
            const unsigned og = xb_add(&bar[XB_TOP], 1u);
            const unsigned tg = og / nx;
            if (og + 1u == (tg + 1u) * nx) xb_add(&bar[XB_TOPGEN], 1u);
            else XB_SPIN(xb_ld(&bar[XB_TOPGEN]) == tg, bar);
            __builtin_amdgcn_fence(__ATOMIC_ACQUIRE, "agent");
            xb_add(&bar[XB_XGEN(x)], 1u);
            asm volatile("s_waitcnt vmcnt(0)" ::: "memory");
        } else {
            XB_SPIN(xb_ld(&bar[XB_XGEN(x)]) == gen, bar);
            __builtin_amdgcn_fence(__ATOMIC_ACQUIRE, "agent");
            asm volatile("s_waitcnt vmcnt(0)" ::: "memory");
        }
    }
    __syncthreads();
}

enum { T_PRO = 0, T_GU, T_DOWN, T_PROJ, T_MIXE, T_SCAN, T_S3, T_WOUT, T_MIXO };
#ifndef DUP_MASK
#define DUP_MASK 0u
#endif
constexpr int NBASE = 17;
__host__ __device__ __forceinline__ void base_info(int ph, int& type, int& layer, int& ffn) {
    if (ph == 0) { type = T_PRO; layer = 0; ffn = 0; return; }
    if (ph <= 9) { layer = 0; const int r = ph - 1; type = r == 0 ? T_GU : r == 1 ? T_DOWN : r == 2 ? T_PROJ : r == 3 ? T_MIXE : r == 4 ? T_SCAN : r == 5 ? T_S3 : r == 6 ? T_WOUT : r == 7 ? T_GU : T_DOWN; ffn = r >= 7; return; }
    layer = 1; const int r = ph - 10; type = r == 0 ? T_GU : r == 1 ? T_DOWN : r == 2 ? T_PROJ : r == 3 ? T_MIXO : r == 4 ? T_WOUT : r == 5 ? T_GU : T_DOWN; ffn = r >= 5;
}
__host__ __device__ __forceinline__ int phase_info(int ph, int& type, int& layer, int& ffn, int& dup) {
    int k = 0;
    for (int b = 0; b < NBASE; ++b) { base_info(b, type, layer, ffn); const int reps = ((DUP_MASK >> type) & 1u) ? 2 : 1; if (ph < k + reps) { dup = ph - k; return -1; } k += reps; }
    return k;
}

__global__ void __launch_bounds__(NTHREADS, 2) fwd(Args args) {
    extern __shared__ __attribute__((aligned(16))) unsigned char lds_raw[];
    if (threadIdx.x < 34) ((LAS unsigned long long*)((LAS unsigned char*)lds_raw + TAB_OFF))[threadIdx.x] = (unsigned long long)args.in[threadIdx.x];
    if (threadIdx.x == 64) { volatile LAS unsigned* st = (volatile LAS unsigned*)((LAS unsigned char*)lds_raw + TAB_OFF + 384); st[0] = 0u; st[1] = 0u; }
    if (threadIdx.x == 0 && args.ph_hi - args.ph_lo > 2) (void)xb_add(&((unsigned*)args.ws)[XB_XCNT(xb_xcc_id())], 1u);
    __syncthreads();
    const int wave_s = __builtin_amdgcn_readfirstlane(threadIdx.x >> 6);
    int ph0 = args.ph_lo;
    if (ph0 == 0) {
        Ctx c; c.lds = (LAS unsigned char*)lds_raw; c.tid = threadIdx.x; c.lane = c.tid & 63; c.wave = wave_s; c.fr = c.lane & 15; c.fq = c.lane >> 4;
        c.tab = (const LAS unsigned long long*)(c.lds + TAB_OFF); c.out = args.out; c.ws = args.ws; c.dry = 0;
        c.XB = (bf16_t*)(args.ws + WS_XB); c.RSP = (float*)(args.ws + WS_RSP); c.DT = (float*)(args.ws + WS_DT); c.CDEC = (float*)(args.ws + WS_CDEC); c.BIG = (bf16_t*)(args.ws + WS_BIG);
        phase_prologue(c, (int)gridDim.x);
        if (args.ph_hi > 1) cg::this_grid().sync();
        ph0 = 1;
    }
    for (int ph = ph0; ph < args.ph_hi; ++ph) {
        int lane_; asm volatile("v_mbcnt_lo_u32_b32 %0, -1, 0\n\tv_mbcnt_hi_u32_b32 %0, -1, %0" : "=v"(lane_));
        int wv_ = wave_s; asm volatile("" : "+s"(wv_));
        const int tid_ = wv_ * 64 + lane_;
        unsigned long long wsi_ = (unsigned long long)args.ws, outi_ = (unsigned long long)args.out; int G = gridDim.x; asm volatile("" : "+s"(wsi_), "+s"(outi_), "+s"(G));
        unsigned char* ws_ = (unsigned char*)(GAS unsigned char*)wsi_; float* out_ = (float*)(GAS float*)outi_;
        Ctx c; c.lds = (LAS unsigned char*)lds_raw; c.tid = tid_; c.lane = c.tid & 63; c.wave = wv_; c.fr = c.lane & 15; c.fq = c.lane >> 4;
        c.tab = (const LAS unsigned long long*)(c.lds + TAB_OFF); c.out = out_; c.ws = ws_; c.dry = 0;
        c.XB = (bf16_t*)(ws_ + WS_XB); c.RSP = (float*)(ws_ + WS_RSP); c.DT = (float*)(ws_ + WS_DT); c.CDEC = (float*)(ws_ + WS_CDEC); c.BIG = (bf16_t*)(ws_ + WS_BIG);
        int type, layer, ffn, dup; (void)phase_info(ph, type, layer, ffn, dup); c.dry = dup;
        if (type == T_GU) {
            pg8::Gemm g{c.XB, (const bf16_t*)(c.ws + WS_WGU + (size_t)(layer * 2 + ffn) * SZ_WGU), DM, MT, 5632, DM};
            pg8::StaticOrder S; S.init(MT, 5632, G, (int)blockIdx.x); pg8::EpiGU E{c.BIG, c.RSP};
            pg8::gemm_phase<pg8::EpiGU>(c.lds, g, S, E, c.tid);
            { const unsigned jm = dup ? 0u : (layer == 0 ? (ffn == 0 ? JOBS_GU_L0F1 : JOBS_GU_L0F2) : (ffn == 0 ? JOBS_GU_L1F1 : 0u));
              if (jm != 0u) { const int nfull = S.nwg % G; const Ctx c2 = fresh_lane(c);
                  if (nfull == 0 || G - nfull < 64) convert_jobs(c2, jm, (int)blockIdx.x, G);
                  else if ((int)blockIdx.x >= nfull) convert_jobs(c2, jm, (int)blockIdx.x - nfull, G - nfull); } }
        } else if (type == T_DOWN || type == T_WOUT) {
            const float alpha = dup ? 0.f : (type == T_DOWN ? 0.5f : 1.0f);
            float* OUTF = (type == T_DOWN && layer == 1 && ffn == 1) ? c.out : nullptr;
            pg8::Gemm g;
            if (type == T_DOWN) { const bf16_t* W = (const bf16_t*)(c.ws + WS_WDN + (size_t)(layer * 2 + ffn) * SZ_WDN);
                mini_res_gemm<11>(c, c.BIG + (size_t)MP * DFF, DFF, W, alpha, G, OUTF); g = pg8::Gemm{c.BIG, W, DFF, MP, DM, DFF}; }
            else { const bf16_t* W = (const bf16_t*)(c.ws + (layer == 0 ? WS_WOUTE : WS_WOUTO)); const int pitch = layer == 0 ? EV_PITCH : OD_PITCH;
                mini_res_gemm<8>(c, c.BIG + (size_t)MP * pitch, pitch, W, alpha, G, OUTF); g = pg8::Gemm{c.BIG, W, pitch, MP, DM, 2048}; }
            pg8::StaticOrder S; S.init(MP, DM, G, (int)blockIdx.x); pg8::EpiRes E{OUTF, c.XB, c.RSP, alpha};
            pg8::gemm_phase<pg8::EpiRes>(c.lds, g, S, E, c.tid);
        } else if (type == T_PROJ) {
            pg8::Gemm g; pg8::EpiProj E; int N;
            if (layer == 0) { N = EV_N; g = pg8::Gemm{c.XB, (const bf16_t*)(c.ws + WS_WINE), DM, MT, EV_N, DM}; E = pg8::EpiProj{c.BIG, EV_PITCH, 0, c.RSP, 0x00F0Fu, c.DT, 18}; }
            else { N = OD_N; g = pg8::Gemm{c.XB, (const bf16_t*)(c.ws + WS_WINO), DM, MT, OD_N, DM}; E = pg8::EpiProj{c.BIG, OD_PITCH, 1024, c.RSP, 0u, nullptr, -1}; }
            pg8::StaticOrder S; S.init(MT, N, G, (int)blockIdx.x);
            pg8::gemm_phase<pg8::EpiProj>(c.lds, g, S, E, c.tid);
            { const unsigned jm = dup ? 0u : (layer == 0 ? JOBS_PROJ_L0 : JOBS_PROJ_L1); const int nfull = S.nwg % G; const Ctx c2 = fresh_lane(c);
              if (nfull == 0 || G - nfull < 64) convert_jobs(c2, jm, (int)blockIdx.x, G);
              else if ((int)blockIdx.x >= nfull) convert_jobs(c2, jm, (int)blockIdx.x - nfull, G - nfull); }
        } else if (type == T_MIXE) {
            for (int u = blockIdx.x; u < 256 + 512 + 256 + 128; u += G) { const Ctx cu = relaunder(c);
                if (u < 256) gmlp_unit(cu, u); else if (u < 768) ssd_s1_unit(cu, u - 256); else if (u < 1024) ssd_sample_unit(cu, u - 768); else gmlp_sample_unit(cu, u - 1024);
            }
            for (int idx = blockIdx.x * NTHREADS + c.tid; idx < 8 * 3 * 1536; idx += G * NTHREADS) { const int col = idx % 1536, r = (idx / 1536) % 3, b = idx / 4608;
                c.out[O_CONV_P + idx] = bf2f(c.BIG[((size_t)b * 4096 + 4093 + r) * EV_PITCH + 3072 + col]); }
        } else if (type == T_SCAN) {
            for (int u = blockIdx.x; u < 1024; u += G) { const Ctx cu = relaunder(c); ssd_scan_unit(cu, u); }
        } else if (type == T_S3) {
            for (int u = blockIdx.x; u < 512; u += G) { const Ctx cu = relaunder(c); ssd_s3_unit(cu, u); }
        } else if (type == T_MIXO) {
            for (int u = blockIdx.x; u < 1024 + 1040; u += G) { const Ctx cu = relaunder(c);
                if (u < 1024) attn_prompt_unit(cu, u); else pool_unit(cu, u - 1024);
            }
            { const int nb = (G >= 64) ? 16 : 0;
              if ((int)blockIdx.x >= nb) for (int m = (int)blockIdx.x - nb; m < 512; m += G - nb) { const Ctx cu = relaunder(c); attn_sample_unit(cu, m); } }
            { const ArgsView a{{c.tab}}; const float* sp = a.in[I_POOL];
              for (int idx = blockIdx.x * NTHREADS + c.tid; idx < 128 * 15 * 256; idx += G * NTHREADS) { const int cq = idx & 255, r = (idx >> 8) % 15, bb = idx / (15 * 256); f32x4 v;
                  if (r < 11) v = *(const f32x4*)(sp + ((size_t)bb * 15 + r + 4) * 1024 + 4 * cq);
                  else { const u32x2 w = *(const u32x2*)(c.BIG + ((size_t)MP + 4 * bb + (r - 11)) * OD_PITCH + OD_N + 4 * cq); v = (f32x4){bflo(w.x), bfhi(w.x), bflo(w.y), bfhi(w.y)}; }
                  *(f32x4*)(c.out + O_POOL_S + ((size_t)bb * 15 + r) * 1024 + 4 * cq) = v; }
              for (int idx = blockIdx.x * NTHREADS + c.tid; idx < 8 * 15 * 256; idx += G * NTHREADS) { const int cq = idx & 255, r = (idx >> 8) % 15, b = idx / (15 * 256);
                  const u32x2 w = *(const u32x2*)(c.BIG + ((size_t)b * 4096 + 4081 + r) * OD_PITCH + OD_N + 4 * cq);
                  *(f32x4*)(c.out + O_POOL_P + ((size_t)b * 15 + r) * 1024 + 4 * cq) = (f32x4){bflo(w.x), bfhi(w.x), bflo(w.y), bfhi(w.y)}; } }
        }
        if (ph + 1 < args.ph_hi) {
            int l2_; asm volatile("v_mbcnt_lo_u32_b32 %0, -1, 0\n\tv_mbcnt_hi_u32_b32 %0, -1, %0" : "=v"(l2_));
            int w2_ = wave_s; asm volatile("" : "+s"(w2_));
            unsigned long long wsb_ = (unsigned long long)args.ws; asm volatile("" : "+s"(wsb_));
            xcd_barrier((unsigned*)(GAS unsigned*)wsb_, (volatile LAS unsigned*)((LAS unsigned char*)lds_raw + TAB_OFF + 384), (w2_ == 0) && (l2_ == 0));
        }
    }
}

#ifndef MK_ONE_LAUNCH
#define MK_ONE_LAUNCH 1
#endif
extern "C" void kernel_launch(void* const* d_in, const int* in_sizes, int n_in, void* d_out, int out_size, void* d_ws, size_t ws_size, hipStream_t stream) {
    static int grid = 0;
    if (grid == 0) {
        int dev = 0, cus = 0, per_cu = 0;
        hipGetDevice(&dev); hipDeviceGetAttribute(&cus, hipDeviceAttributeMultiprocessorCount, dev);
        hipFuncSetAttribute((const void*)fwd, hipFuncAttributeMaxDynamicSharedMemorySize, LDS_BYTES);
        if (hipOccupancyMaxActiveBlocksPerMultiprocessor(&per_cu, (const void*)fwd, NTHREADS, LDS_BYTES) != hipSuccess || per_cu < 1) per_cu = 1;
        (void)hipGetLastError();
        grid = cus * per_cu;
        if (n_in != 34 || (size_t)out_size != O_END || ws_size < WS_END) fprintf(stderr, "kernel_launch: unexpected sizes n_in %d out %d ws %zu (need %zu)\n", n_in, out_size, ws_size, (size_t)WS_END);
    }
    Args a{};
    for (int i = 0; i < 34; ++i) a.in[i] = (const float*)d_in[i];
    a.out = (float*)d_out; a.ws = (unsigned char*)d_ws;
#if MK_ONE_LAUNCH
    { int t_, l_, f_, d_; a.ph_lo = 0; a.ph_hi = phase_info(1 << 20, t_, l_, f_, d_); }
    (void)hipMemsetAsync(d_ws, 0, 16384, stream);
    void* kargs[] = {&a};
    hipError_t e = hipLaunchCooperativeKernel((const void*)fwd, dim3(grid), dim3(NTHREADS), kargs, LDS_BYTES, stream);
    if (e != hipSuccess) fprintf(stderr, "cooperative launch failed: %s (grid %d)\n", hipGetErrorString(e), grid);
#else
    int t_, l_, f_, d_; const int NPHASES = phase_info(1 << 20, t_, l_, f_, d_);
    for (int ph = 0; ph < NPHASES; ++ph) { a.ph_lo = ph; a.ph_hi = ph + 1; hipLaunchKernelGGL(fwd, dim3(grid), dim3(NTHREADS), LDS_BYTES, stream, a); }
#endif
}
```

```cpp
#include <hip/hip_runtime.h>
#include <hip/hip_cooperative_groups.h>
#include <cstdio>
#include <cstdint>
namespace cg = cooperative_groups;

#define LAS __attribute__((address_space(3)))
#define GAS __attribute__((address_space(1)))
template <class T> __device__ __forceinline__ T* as_global(T* p) { return (T*)(GAS T*)p; }
typedef unsigned short bf16_t;
typedef short bf16x8 __attribute__((ext_vector_type(8)));
typedef float f32x4 __attribute__((ext_vector_type(4)));
typedef float f32x2 __attribute__((ext_vector_type(2)));
typedef unsigned u32x4 __attribute__((ext_vector_type(4)));
typedef unsigned u32x2 __attribute__((ext_vector_type(2)));

constexpr int DM = 1024, MP = 32768, MS = 512, MT = MP + MS;
constexpr int DFF = 2816;
constexpr int EV_N = 4864, EV_PITCH = 4864;
constexpr int OD_N = 2560, OD_PITCH = 3584;
constexpr float EPS = 1e-6f;
constexpr int NWAVES = 8, NTHREADS = 512;
constexpr int LDS_BYTES = 147456;

constexpr size_t O_Y = 0;
constexpr size_t O_AV = (size_t)MT * DM;
constexpr size_t O_SSM_P = O_AV + 524288;
constexpr size_t O_SSM_S = O_SSM_P + 1048576;
constexpr size_t O_CONV_P = O_SSM_S + 16777216;
constexpr size_t O_CONV_S = O_CONV_P + 36864;
constexpr size_t O_POOL_P = O_CONV_S + 589824;
constexpr size_t O_POOL_S = O_POOL_P + 122880;
constexpr size_t O_K_P = O_POOL_S + 1966080;
constexpr size_t O_K_S = O_K_P + 262144;
constexpr size_t O_V_P = O_K_S + 4194304;
constexpr size_t O_V_S = O_V_P + 262144;
constexpr size_t O_END = O_V_S + 4194304;

constexpr size_t WS_WMB = 65536;
constexpr size_t WS_RSW = 524288;
constexpr size_t WS_WGU = 1u << 20;
constexpr size_t SZ_WGU = (size_t)5632 * 1024 * 2;
constexpr size_t WS_WDN = WS_WGU + 4 * SZ_WGU;
constexpr size_t SZ_WDN = (size_t)1024 * 2816 * 2;
constexpr size_t WS_WINE = WS_WDN + 4 * SZ_WDN;
constexpr size_t WS_WOUTE = WS_WINE + (size_t)EV_N * 1024 * 2;
constexpr size_t WS_WINO = WS_WOUTE + (size_t)1024 * 2048 * 2;
constexpr size_t WS_WOUTO = WS_WINO + (size_t)OD_N * 1024 * 2;
constexpr size_t WS_CLIN = WS_WOUTO + (size_t)1024 * 2048 * 2;
constexpr size_t WS_XB = WS_CLIN + (size_t)4 * 256 * 256 * 2;
constexpr size_t WS_RSP = WS_XB + (size_t)MT * 1024 * 2;
constexpr size_t WS_DT = WS_RSP + (size_t)MT * 16 * 4;
constexpr size_t WS_CDEC = WS_DT + (size_t)MT * 16 * 4;
constexpr size_t WS_BIG = WS_CDEC + 65536;
constexpr size_t WS_END = WS_BIG + (size_t)MT * EV_PITCH * 2;

__device__ const unsigned char T5B[128] = {0, 1, 2, 3, 4, 5, 6, 7, 8, 9, 10, 11, 12, 13, 14, 15, 16, 16, 16, 17, 17, 18, 18, 18, 19, 19, 19, 20, 20, 20, 20, 21, 21, 21, 21, 22, 22, 22, 22, 22, 23, 23, 23, 23, 23, 23, 24, 24, 24, 24, 24, 24, 25, 25, 25, 25, 25, 25, 25, 26, 26, 26, 26, 26, 26, 26, 26, 27, 27, 27, 27, 27, 27, 27, 27, 27, 27, 28, 28, 28, 28, 28, 28, 28, 28, 28, 28, 29, 29, 29, 29, 29, 29, 29, 29, 29, 29, 29, 29, 30, 30, 30, 30, 30, 30, 30, 30, 30, 30, 30, 30, 30, 30, 31, 31, 31, 31, 31, 31, 31, 31, 31, 31, 31, 31, 31, 31, 31};

__device__ __forceinline__ float bf2f(bf16_t v) { return __uint_as_float((unsigned)v << 16); }
__device__ __forceinline__ float bflo(unsigned w) { return __uint_as_float(w << 16); }
__device__ __forceinline__ float bfhi(unsigned w) { return __uint_as_float(w & 0xffff0000u); }
typedef __bf16 bf16v2 __attribute__((ext_vector_type(2)));
__device__ __forceinline__ unsigned pk2(float lo, float hi) { const f32x2 v = {lo, hi}; const bf16v2 b = __builtin_convertvector(v, bf16v2); return __builtin_bit_cast(unsigned, b); }
__device__ __forceinline__ unsigned f2bf(float f) { return pk2(f, 0.f) & 0xffffu; }
__device__ __forceinline__ float silu_f(float x) { return x * __builtin_amdgcn_rcpf(1.f + __expf(-x)); }
__device__ __forceinline__ float gelu_tanh(float x) { const float t = 1.5957691216f * (x + 0.044715f * x * x * x); return x * __builtin_amdgcn_rcpf(1.f + __expf(-t)); }
__device__ __forceinline__ float softplus_f(float x) { return fmaxf(x, 0.f) + log1pf(__expf(-fabsf(x))); }
__device__ __forceinline__ float wave_sum(float v) {
#pragma unroll
    for (int o = 1; o < 64; o <<= 1) v += __shfl_xor(v, o);
    return v;
}
__device__ __forceinline__ void unpack8(u32x4 w, float (&o)[8]) {
    o[0] = bflo(w.x); o[1] = bfhi(w.x); o[2] = bflo(w.y); o[3] = bfhi(w.y); o[4] = bflo(w.z); o[5] = bfhi(w.z); o[6] = bflo(w.w); o[7] = bfhi(w.w);
}
__device__ __forceinline__ u32x4 pack8(const float (&o)[8]) { u32x4 w; w.x = pk2(o[0], o[1]); w.y = pk2(o[2], o[3]); w.z = pk2(o[4], o[5]); w.w = pk2(o[6], o[7]); return w; }
__device__ __forceinline__ f32x4 mfma16(bf16x8 a, bf16x8 b, f32x4 c) { return __builtin_amdgcn_mfma_f32_16x16x32_bf16(a, b, c, 0, 0, 0); }
#define LDS_BF8(p) (*(const LAS bf16x8*)(p))

namespace pg8 {
constexpr int BM = 256, BK = 64, HALF = 128, HTB = HALF * BK * 2, STAGE_BYTES = 8 * HTB, NXCD = 8, WGM = 8;
__device__ __forceinline__ int lds_byte(int r, int c) { const int st = (r >> 4) * 2 + (c >> 5), rr = r & 15, cc = c & 31, ob = rr * 64 + cc * 2; return st * 1024 + (ob ^ (((ob >> 9) & 1) << 5)); }
__device__ __forceinline__ void stage_rc(int b, int& R, int& C) { const int st = b / 1024, sb = b % 1024, swz = sb ^ (((sb >> 9) & 1) << 5); R = (st >> 1) * 16 + swz / 64; C = (st & 1) * 32 + (swz % 64) / 2; }
__device__ __forceinline__ int perm32(int rho) { const int n = rho >> 4, i = rho & 15; return 8 * (i >> 2) + 4 * n + (i & 3); }

struct Unit { int pm, pn; };
struct Gemm { const bf16_t* A; const bf16_t* Bt; int lda, M, N, K; };

struct StaticOrder {
    int nM, nN, nwg, G, c;
    __device__ void init(int M, int N, int G_, int c_) { nM = M / BM; nN = N / BM; nwg = nM * nN; G = G_; c = c_; }
    __device__ bool next(int i, Unit& u) const {
        const long L = (long)i * G + c; if (L >= nwg) return false;
        int wgid = (int)L; { const int q = nwg / NXCD, r = nwg % NXCD, xcd = wgid % NXCD, off = wgid / NXCD; wgid = (xcd < r ? xcd * (q + 1) : r * (q + 1) + (xcd - r) * q) + off; }
        const int nig = WGM * nN, gid = wgid / nig, fm = gid * WGM, gsz = (nM - fm) < WGM ? (nM - fm) : WGM;
        u.pm = fm + ((wgid % nig) % gsz); u.pn = (wgid % nig) / gsz; return true;
    }
};

__device__ __forceinline__ float row_rs(const float* rsp, int row, int fq) {
    const f32x4 q = *(const f32x4*)(rsp + (size_t)row * 16 + 4 * fq);
    float s = (q[0] + q[1]) + (q[2] + q[3]); s += __shfl_xor(s, 16); s += __shfl_xor(s, 32);
    return rsqrtf(s * (1.0f / 1024.0f) + EPS);
}

__device__ __forceinline__ void row_rs8(const float* rsp, int row0, int fq, float (&rs)[8]) {
    f32x4 q[8];
#pragma unroll
    for (int r = 0; r < 8; ++r) q[r] = *(const f32x4*)(rsp + (size_t)(row0 + (r >> 2) * HALF + (r & 3) * 16) * 16 + 4 * fq);
#pragma unroll
    for (int r = 0; r < 8; ++r) { float s = (q[r][0] + q[r][1]) + (q[r][2] + q[r][3]); s += __shfl_xor(s, 16); s += __shfl_xor(s, 32); rs[r] = rsqrtf(s * (1.0f / 1024.0f) + EPS); }
}
struct EpiGU {
    static constexpr bool PERM = true;
    bf16_t* HID; const float* rsp;
    __device__ __forceinline__ void operator()(const f32x4 (&acc)[2][2][4][2], const Unit& u, int wr, int wc, int fr, int fq) const {
        const int row0 = u.pm * BM + wr * 64 + fr, col0 = u.pn * 128 + wc * 32 + 8 * fq;
        float rs8[8]; row_rs8(rsp, row0, fq, rs8);
#pragma unroll
        for (int ai = 0; ai < 2; ++ai)
#pragma unroll
            for (int m = 0; m < 4; ++m) {
                const int row = row0 + ai * HALF + m * 16; const float rs = rs8[ai * 4 + m];
                float o[8];
#pragma unroll
                for (int n = 0; n < 2; ++n)
#pragma unroll
                    for (int j = 0; j < 4; ++j) { const float g = acc[ai][0][m][n][j] * rs, up = acc[ai][1][m][n][j] * rs; o[4 * n + j] = silu_f(g) * up; }
                *(u32x4*)(HID + (size_t)row * DFF + col0) = pack8(o);
            }
    }
};
struct EpiRes {
    static constexpr bool PERM = true;
    float* OUT; bf16_t* XB; float* rsp; float alpha;
    __device__ __forceinline__ void operator()(const f32x4 (&acc)[2][2][4][2], const Unit& u, int wr, int wc, int fr, int fq) const {
        const int row0 = u.pm * BM + wr * 64 + fr, col0 = u.pn * BM + wc * 32 + 8 * fq;
#pragma unroll
        for (int ai = 0; ai < 2; ++ai) {
            u32x4 xin[4][2];
#pragma unroll
            for (int m = 0; m < 4; ++m)
#pragma unroll
                for (int bj = 0; bj < 2; ++bj) xin[m][bj] = *(const u32x4*)(XB + (size_t)(row0 + ai * HALF + m * 16) * DM + col0 + bj * HALF);
#pragma unroll
            for (int m = 0; m < 4; ++m) {
                const int row = row0 + ai * HALF + m * 16; float ss = 0.f;
#pragma unroll
                for (int bj = 0; bj < 2; ++bj) {
                    const size_t off = (size_t)row * DM + col0 + bj * HALF;
                    float h[8]; unpack8(xin[m][bj], h);
#pragma unroll
                    for (int n = 0; n < 2; ++n)
#pragma unroll
                        for (int j = 0; j < 4; ++j) { h[4 * n + j] += acc[ai][bj][m][n][j] * alpha; ss += h[4 * n + j] * h[4 * n + j]; }
                    if (OUT != nullptr) { *(f32x4*)(OUT + off) = (f32x4){h[0], h[1], h[2], h[3]}; *(f32x4*)(OUT + off + 4) = (f32x4){h[4], h[5], h[6], h[7]}; }
                    else *(u32x4*)(XB + off) = pack8(h);
                }
                ss += __shfl_xor(ss, 16); ss += __shfl_xor(ss, 32);
                if (fq == 0) rsp[(size_t)row * 16 + u.pn * 4 + wc] = ss;
            }
        }
    }
};
struct EpiProj {
    static constexpr bool PERM = true;
    bf16_t* O; int pitch, coloff; const float* rsp; unsigned gelu_mask; float* DT; int dt_pn;
    __device__ __forceinline__ void operator()(const f32x4 (&acc)[2][2][4][2], const Unit& u, int wr, int wc, int fr, int fq) const {
        const int row0 = u.pm * BM + wr * 64 + fr, col0 = u.pn * BM + wc * 32 + 8 * fq;
        const bool ge = (gelu_mask >> u.pn) & 1u; const bool dtw = (DT != nullptr) && (u.pn == dt_pn) && (wc == 0) && (fq < 2);
        float rs8[8]; row_rs8(rsp, row0, fq, rs8);
#pragma unroll
        for (int ai = 0; ai < 2; ++ai)
#pragma unroll
            for (int m = 0; m < 4; ++m) {
                const int row = row0 + ai * HALF + m * 16; const float rs = rs8[ai * 4 + m];
#pragma unroll
                for (int bj = 0; bj < 2; ++bj) {
                    float o[8];
#pragma unroll
                    for (int n = 0; n < 2; ++n)
#pragma unroll
                        for (int j = 0; j < 4; ++j) { float v = acc[ai][bj][m][n][j] * rs; if (ge) v = gelu_tanh(v); o[4 * n + j] = v; }
                    *(u32x4*)(O + (size_t)row * pitch + coloff + col0 + bj * HALF) = pack8(o);
                    if (bj == 0 && dtw) { *(f32x4*)(DT + (size_t)row * 16 + 8 * fq) = (f32x4){o[0], o[1], o[2], o[3]}; *(f32x4*)(DT + (size_t)row * 16 + 8 * fq + 4) = (f32x4){o[4], o[5], o[6], o[7]}; }
                }
            }
    }
};

template <class Epi>
__device__ __forceinline__ void gemm_phase(LAS unsigned char* lds, const Gemm g, const StaticOrder& S, const Epi& E, const int tid) {
    const int wid = __builtin_amdgcn_readfirstlane(tid >> 6), lane = tid & 63, wr = wid >> 2, wc = wid & 3, fr = lane & 15, fq = lane >> 4;
    const int K = g.K, nt = K / BK, lda = g.lda;
    unsigned voffA[2], voffB[2];
#pragma unroll
    for (int i = 0; i < 2; ++i) { int R, C; stage_rc(tid * 16 + i * 8192, R, C); const int Rb = Epi::PERM ? ((R & ~31) + perm32(R & 31)) : R;
        voffA[i] = (unsigned)(R * lda + C) * 2u; voffB[i] = (unsigned)(Rb * K + C) * 2u; }
    const size_t kstep = (size_t)(BK * 2);
    const size_t hstepA = (size_t)HALF * lda * 2, hstepB = (size_t)HALF * K * 2;
    const size_t tstepA = 2 * hstepA, tstepB = 2 * hstepB;
    const unsigned ldsw = (unsigned)wid * 1024u;
    const int aoff = lds_byte(wr * 64 + fr, fq * 8), boff = lds_byte(wc * 32 + fr, fq * 8);
#define PG8_SA(b, h) (((b) * 2 + (h)) * HTB)
#define PG8_SB(b, h) ((4 + (b) * 2 + (h)) * HTB)
#define PG8_STAGE(bufoff, gbase, voff) do { _Pragma("unroll") for (int _i = 0; _i < 2; ++_i) \
        __builtin_amdgcn_global_load_lds((const unsigned*)((const char*)(gbase) + (voff)[_i]), (LAS unsigned*)(lds + (bufoff) + ldsw + _i * 8192), 16, 0, 0); } while (0)
#define PG8_LDA(dst, b, h) do { _Pragma("unroll") for (int m = 0; m < 4; ++m) _Pragma("unroll") for (int k = 0; k < 2; ++k) dst[m][k] = *(const LAS bf16x8*)(lds + PG8_SA(b, h) + aoff + m * 2048 + k * 1024); } while (0)
#define PG8_LDB(dst, b, h) do { _Pragma("unroll") for (int n = 0; n < 2; ++n) _Pragma("unroll") for (int k = 0; k < 2; ++k) dst[n][k] = *(const LAS bf16x8*)(lds + PG8_SB(b, h) + boff + n * 2048 + k * 1024); } while (0)
#define PG8_MMA(ai, bj, At, Bt) do { __builtin_amdgcn_s_setprio(1); _Pragma("unroll") for (int m = 0; m < 4; ++m) _Pragma("unroll") for (int n = 0; n < 2; ++n) _Pragma("unroll") for (int k = 0; k < 2; ++k) \
        acc[ai][bj][m][n] = __builtin_amdgcn_mfma_f32_16x16x32_bf16(Bt[n][k], At[m][k], acc[ai][bj][m][n], 0, 0, 0); __builtin_amdgcn_s_setprio(0); } while (0)
#define PG8_WAIT_V(n) asm volatile("s_waitcnt vmcnt(" #n ")" ::: "memory")
#define PG8_WAIT_L(n) asm volatile("s_waitcnt lgkmcnt(" #n ")" ::: "memory")
#define PG8_BAR __builtin_amdgcn_s_barrier()
#define PG8_SCHED __builtin_amdgcn_sched_barrier(0)
    Unit cur, nxt; int ui = 0;
    if (!S.next(0, cur)) return;
    f32x4 acc[2][2][4][2];
#pragma unroll
    for (int a = 0; a < 2; ++a)
#pragma unroll
        for (int b = 0; b < 2; ++b)
#pragma unroll
            for (int m = 0; m < 4; ++m)
#pragma unroll
                for (int n = 0; n < 2; ++n) acc[a][b][m][n] = (f32x4){0.f, 0.f, 0.f, 0.f};
    bf16x8 At[4][2], B0[2][2], B1[2][2];
    const char* cA = (const char*)g.A + (size_t)cur.pm * tstepA; const char* cB = (const char*)g.Bt + (size_t)cur.pn * tstepB;
    PG8_STAGE(PG8_SB(0, 0), cB, voffB); PG8_STAGE(PG8_SB(0, 1), cB + hstepB, voffB); PG8_STAGE(PG8_SA(0, 0), cA, voffA); PG8_STAGE(PG8_SA(0, 1), cA + hstepA, voffA);
    if (wr == 1) PG8_BAR;
    PG8_WAIT_V(2); PG8_BAR;
    PG8_STAGE(PG8_SB(1, 0), cB + kstep, voffB); PG8_STAGE(PG8_SA(1, 0), cA + kstep, voffA); PG8_STAGE(PG8_SB(1, 1), cB + hstepB + kstep, voffB);
    PG8_WAIT_V(6); PG8_BAR;
    for (;;) {
        const bool has_next = S.next(ui + 1, nxt);
        const char* nA = has_next ? (const char*)g.A + (size_t)nxt.pm * tstepA : cA; const char* nB = has_next ? (const char*)g.Bt + (size_t)nxt.pn * tstepB : cB;
        for (int t = 0; t < nt; t += 2) {
            const bool last = (t == nt - 2);
            const char* a1 = cA + (size_t)(t + 1) * kstep;
            const char* a2 = last ? nA : cA + (size_t)(t + 2) * kstep; const char* b2 = last ? nB : cB + (size_t)(t + 2) * kstep;
            const char* a3 = a2 + kstep; const char* b3 = b2 + kstep;
            PG8_LDB(B0, 0, 0); PG8_LDB(B1, 0, 1); PG8_SCHED; PG8_LDA(At, 0, 0); PG8_STAGE(PG8_SA(1, 1), a1 + hstepA, voffA);
            PG8_WAIT_V(8); PG8_WAIT_L(0); PG8_BAR; PG8_MMA(0, 0, At, B0); PG8_MMA(0, 1, At, B1); PG8_BAR; PG8_SCHED;
            PG8_LDA(At, 0, 1); PG8_STAGE(PG8_SB(0, 0), b2, voffB); PG8_STAGE(PG8_SB(0, 1), b2 + hstepB, voffB); PG8_STAGE(PG8_SA(0, 0), a2, voffA);
            PG8_WAIT_V(8); PG8_WAIT_L(0); PG8_BAR; PG8_MMA(1, 0, At, B0); PG8_MMA(1, 1, At, B1); PG8_BAR; PG8_SCHED;
            PG8_LDB(B0, 1, 0); PG8_LDB(B1, 1, 1); PG8_SCHED; PG8_LDA(At, 1, 0); PG8_STAGE(PG8_SA(0, 1), a2 + hstepA, voffA);
            PG8_WAIT_V(8); PG8_WAIT_L(0); PG8_BAR; PG8_MMA(0, 0, At, B0); PG8_MMA(0, 1, At, B1); PG8_BAR; PG8_SCHED;
            PG8_LDA(At, 1, 1); PG8_STAGE(PG8_SB(1, 0), b3, voffB); PG8_STAGE(PG8_SB(1, 1), b3 + hstepB, voffB); PG8_STAGE(PG8_SA(1, 0), a3, voffA);
            PG8_WAIT_V(8); PG8_WAIT_L(0); PG8_BAR; PG8_MMA(1, 0, At, B0); PG8_MMA(1, 1, At, B1); PG8_BAR; PG8_SCHED;
        }
        if (wr == 0) PG8_BAR;
        E(acc, cur, wr, wc, fr, fq);
        if (!has_next) break;
#pragma unroll
        for (int a = 0; a < 2; ++a)
#pragma unroll
            for (int b = 0; b < 2; ++b)
#pragma unroll
                for (int m = 0; m < 4; ++m)
#pragma unroll
                    for (int n = 0; n < 2; ++n) acc[a][b][m][n] = (f32x4){0.f, 0.f, 0.f, 0.f};
        cur = nxt; cA = nA; cB = nB; ++ui;
        if (wr == 1) PG8_BAR;
    }
    PG8_WAIT_V(0);
    PG8_BAR;
#undef PG8_SA
#undef PG8_SB
#undef PG8_STAGE
#undef PG8_LDA
#undef PG8_LDB
#undef PG8_MMA
#undef PG8_WAIT_V
#undef PG8_WAIT_L
#undef PG8_BAR
#undef PG8_SCHED
}
}

struct Args { const float* in[34]; float* out; unsigned char* ws; int ph_lo, ph_hi; };
enum { I_XP = 0, I_XS, I_SSM, I_CONV, I_POOL, I_CK, I_CV, I_F1N, I_F1GU, I_F1DN, I_MIXN, I_F2N, I_F2GU, I_F2DN, I_EWIN, I_EWOUT, I_ALNG, I_ALNB, I_AWS, I_ABS,
       I_CONVW, I_CONVB, I_DTB, I_ALOG, I_DSKIP, I_BNG, I_OWIN, I_OWOUT, I_CLIN, I_CSCALE, I_QN, I_KN, I_SINKS, I_REL };

constexpr int TAB_OFF = LDS_BYTES - 512;
struct InView { const LAS unsigned long long* t; __device__ __forceinline__ const float* operator[](int i) const { return (const float*)(GAS const float*)t[i]; } };
struct ArgsView { InView in; };
struct Ctx {
    LAS unsigned char* lds; int tid, lane, wave, fr, fq;
    const LAS unsigned long long* tab; float* out; unsigned char* ws; int dry;
    bf16_t* XB; float* RSP; float* DT; float* CDEC; bf16_t* BIG;
};

__device__ __forceinline__ Ctx relaunder(const Ctx& c) { Ctx d = c; int l; asm volatile("v_mbcnt_lo_u32_b32 %0, -1, 0\n\tv_mbcnt_hi_u32_b32 %0, -1, %0" : "=v"(l)); d.lane = l; d.tid = c.wave * 64 + l; d.fr = l & 15; d.fq = l >> 4; return d; }

__device__ __forceinline__ Ctx fresh_lane(const Ctx& c) { Ctx d = c; int l; asm volatile("v_mbcnt_lo_u32_b32 %0, -1, 0\n\tv_mbcnt_hi_u32_b32 %0, -1, %0" : "=v"(l)); d.lane = l; d.tid = c.wave * 64 + l; d.fr = l & 15; d.fq = l >> 4; return d; }

struct WJob { const float* W; bf16_t* WT; const float* gain; int K, Nsrc, Ndst, mode, gk_lo, gk_hi; };
__device__ __forceinline__ int srccol(int mode, int n) {
    if (mode == 0) return n;
    if (mode == 1) { const int t = n >> 8, r = n & 255; return r < 128 ? 128 * t + r : DFF + 128 * t + (r - 128); }
    if (mode == 2) { if (n < 1024) return n; if (n < 2048) return n + 1024; if (n < 3072) return n - 1024; if (n < 4624) return n; return -1; }
    return n < 1536 ? n + 1024 : n - 1536;
}
__device__ __forceinline__ void transpose_item(const WJob& J, LAS float* scr, int item, int lane) {
    const int nblk = J.Ndst / 32, kb = item / nblk, nb = item % nblk, k0 = 64 * kb, n0 = 32 * nb;
    const int nq = lane & 7, kr = lane >> 3; const int sc = srccol(J.mode, n0 + 4 * nq);
#pragma unroll
    for (int i = 0; i < 8; ++i) { const int kk = 8 * i + kr; const int k = k0 + kk;
        f32x4 v = sc >= 0 ? __builtin_nontemporal_load((const f32x4*)(J.W + (size_t)k * J.Nsrc + sc)) : (f32x4){0.f, 0.f, 0.f, 0.f};
        if (J.gain != nullptr && k >= J.gk_lo && k < J.gk_hi) v = v * J.gain[k - J.gk_lo];
        scr[kk * 33 + 4 * nq] = v[0]; scr[kk * 33 + 4 * nq + 1] = v[1]; scr[kk * 33 + 4 * nq + 2] = v[2]; scr[kk * 33 + 4 * nq + 3] = v[3]; }
    asm volatile("s_waitcnt lgkmcnt(0)" ::: "memory");
    const int c = lane & 7;
#pragma unroll
    for (int j = 0; j < 4; ++j) { const int n = (lane >> 3) + 8 * j; const LAS float* s = scr + (8 * c) * 33 + n;
        u32x4 o; o.x = pk2(s[0 * 33], s[1 * 33]); o.y = pk2(s[2 * 33], s[3 * 33]); o.z = pk2(s[4 * 33], s[5 * 33]); o.w = pk2(s[6 * 33], s[7 * 33]);
        *(u32x4*)(J.WT + (size_t)(n0 + n) * J.K + k0 + 8 * c) = o; }
    asm volatile("s_waitcnt lgkmcnt(0)" ::: "memory");
}
constexpr int NJOBS = 16;
__device__ __forceinline__ WJob make_job(const Ctx& c, int j) {
    const ArgsView a{{c.tab}}; WJob J; J.gain = nullptr; J.gk_lo = 0; J.gk_hi = 0; J.mode = 0;
    if (j < 8) {
        const int layer = j >> 2, f = (j >> 1) & 1, dn = j & 1;
        if (!dn) { J.W = (f ? a.in[I_F2GU] : a.in[I_F1GU]) + (size_t)layer * 1024 * 5632; J.WT = (bf16_t*)(c.ws + WS_WGU + (size_t)(layer * 2 + f) * SZ_WGU);
            J.K = 1024; J.Nsrc = 5632; J.Ndst = 5632; J.mode = 1; J.gain = (f ? a.in[I_F2N] : a.in[I_F1N]) + layer * 1024; J.gk_lo = 0; J.gk_hi = 1024; }
        else { J.W = (f ? a.in[I_F2DN] : a.in[I_F1DN]) + (size_t)layer * 2816 * 1024; J.WT = (bf16_t*)(c.ws + WS_WDN + (size_t)(layer * 2 + f) * SZ_WDN);
            J.K = 2816; J.Nsrc = 1024; J.Ndst = 1024; }
    } else if (j == 8) { J.W = a.in[I_EWIN]; J.WT = (bf16_t*)(c.ws + WS_WINE); J.K = 1024; J.Nsrc = 4624; J.Ndst = EV_N; J.mode = 2; J.gain = a.in[I_MIXN]; J.gk_hi = 1024; }
    else if (j == 9) { J.W = a.in[I_EWOUT]; J.WT = (bf16_t*)(c.ws + WS_WOUTE); J.K = 2048; J.Nsrc = 1024; J.Ndst = 1024; J.gain = a.in[I_BNG]; J.gk_lo = 1024; J.gk_hi = 2048; }
    else if (j == 10) { J.W = a.in[I_OWIN]; J.WT = (bf16_t*)(c.ws + WS_WINO); J.K = 1024; J.Nsrc = 2560; J.Ndst = OD_N; J.mode = 3; J.gain = a.in[I_MIXN] + 1024; J.gk_hi = 1024; }
    else if (j == 11) { J.W = a.in[I_OWOUT]; J.WT = (bf16_t*)(c.ws + WS_WOUTO); J.K = 2048; J.Nsrc = 1024; J.Ndst = 1024; J.gain = a.in[I_CSCALE]; J.gk_lo = 0; J.gk_hi = 1024; }
    else { const int gi = j - 12; J.W = a.in[I_CLIN] + (size_t)gi * 65536; J.WT = (bf16_t*)(c.ws + WS_CLIN) + (size_t)gi * 65536; J.K = 256; J.Nsrc = 256; J.Ndst = 256; }
    return J;
}
__device__ __forceinline__ int job_items(int j) {
    if (j < 8) return (j & 1) ? (2816 / 64) * (1024 / 32) : (1024 / 64) * (5632 / 32);
    if (j == 8) return (1024 / 64) * (EV_N / 32);
    if (j == 9 || j == 11) return (2048 / 64) * (1024 / 32);
    if (j == 10) return (1024 / 64) * (OD_N / 32);
    return (256 / 64) * (256 / 32);
}
__device__ __forceinline__ void convert_jobs(const Ctx& c, unsigned mask, int wgi, int nwg) {
    LAS float* scr = (LAS float*)(c.lds + c.wave * 16384);
    const int gw = wgi * NWAVES + c.wave, NGW = nwg * NWAVES;
    int base = 0;
    for (int j = 0; j < NJOBS; ++j) {
        if (!((mask >> j) & 1u)) continue;
        const int ni = job_items(j);
        int it = gw - (base % NGW); if (it < 0) it += NGW;
        if (it < ni) { const WJob J = make_job(c, j); for (; it < ni; it += NGW) transpose_item(J, scr, it, c.lane); }
        base += ni;
    }
}
constexpr unsigned JOBS_PRO = 1u << 0;
constexpr unsigned JOBS_GU_L0F1 = (1u << 1) | (1u << 8) | (1u << 9);
constexpr unsigned JOBS_PROJ_L0 = (1u << 2);
constexpr unsigned JOBS_GU_L0F2 = (1u << 3) | (1u << 4);
constexpr unsigned JOBS_GU_L1F1 = (1u << 10) | (0xFu << 12) | (1u << 5);
constexpr unsigned JOBS_PROJ_L1 = (1u << 11) | (1u << 6) | (1u << 7);
__device__ __forceinline__ void phase_prologue(const Ctx& c, int G) {
    convert_jobs(c, JOBS_PRO, (int)blockIdx.x, G);
    const int gw = blockIdx.x * NWAVES + c.wave, NGW = G * NWAVES;
    { const ArgsView a2{{c.tab}}; const float* wsp = a2.in[I_AWS]; unsigned* wmb = (unsigned*)(c.ws + WS_WMB); float* rsw = (float*)(c.ws + WS_RSW);
      for (int r = gw; r < 1024; r += NGW) { const int i = r & 127; const f32x2 w = *(const f32x2*)(wsp + (size_t)r * 128 + 2 * c.lane);
          const float w0 = (2 * c.lane <= i) ? w[0] : 0.f, w1 = (2 * c.lane + 1 <= i) ? w[1] : 0.f;
          wmb[(size_t)r * 64 + c.lane] = pk2(w0, w1); const float sm = wave_sum(w0 + w1); if (c.lane == 0) rsw[r] = sm; } }
    const ArgsView a{{c.tab}}; const float* xp = a.in[I_XP]; const float* xs = a.in[I_XS];
    for (int m = gw; m < MT; m += NGW) {
        const f32x4* src = (const f32x4*)(m < MP ? xp + (size_t)m * DM : xs + (size_t)(m - MP) * DM) + c.lane;
        f32x4 v[4]; float s = 0.f;
#pragma unroll
        for (int j = 0; j < 4; ++j) { v[j] = __builtin_nontemporal_load(src + 64 * j); s += (v[j][0] * v[j][0] + v[j][1] * v[j][1]) + (v[j][2] * v[j][2] + v[j][3] * v[j][3]); }
        s = wave_sum(s);
        u32x2* xo = (u32x2*)(c.XB + (size_t)m * DM) + c.lane;
#pragma unroll
        for (int j = 0; j < 4; ++j) { u32x2 w; w.x = pk2(v[j][0], v[j][1]); w.y = pk2(v[j][2], v[j][3]); xo[64 * j] = w; }
        if (c.lane < 16) c.RSP[(size_t)m * 16 + c.lane] = c.lane == 0 ? s : 0.f;
    }
}

__device__ __forceinline__ void gmlp_unit(const Ctx& c, int unit) {
    const ArgsView a{{c.tab}}; bf16_t* P = c.BIG; const size_t R0 = (size_t)unit * 128;
    LAS f32x2* PART = (LAS f32x2*)c.lds; LAS float* RS = (LAS float*)(c.lds + 4096); LAS float* LNG = (LAS float*)(c.lds + 4608); LAS float* LNB = (LAS float*)(c.lds + 8704);
    LAS bf16_t* Vt = (LAS bf16_t*)(c.lds + 12800); LAS bf16_t* Wm = (LAS bf16_t*)(c.lds + 12800 + 34816);
    const bf16_t* wmb = (const bf16_t*)(c.ws + WS_WMB); const float* rsw = (const float*)(c.ws + WS_RSW); const float* bs = a.in[I_ABS];
    const int j = c.tid & 127, eb = c.tid >> 7, wi = c.tid >> 2, wjs = (c.tid & 3) * 32;
    u32x4 vr[8][4];
#pragma unroll
    for (int h = 0; h < 8; ++h)
#pragma unroll
        for (int q = 0; q < 4; ++q) vr[h][q] = *(const u32x4*)(P + (R0 + j) * EV_PITCH + 2048 + h * 128 + eb * 32 + 8 * q);
    u32x4 wreg[4];
#pragma unroll
    for (int q = 0; q < 4; ++q) wreg[q] = *(const u32x4*)(wmb + (size_t)wi * 128 + wjs + 8 * q);
    { const f32x2 g2 = *(const f32x2*)(a.in[I_ALNG] + 2 * c.tid), b2 = *(const f32x2*)(a.in[I_ALNB] + 2 * c.tid);
      *(LAS f32x2*)(LNG + 2 * c.tid) = g2; *(LAS f32x2*)(LNB + 2 * c.tid) = b2; }
    { float sm = 0.f, sq = 0.f;
#pragma unroll
      for (int h = 0; h < 8; ++h)
#pragma unroll
          for (int q = 0; q < 4; ++q) { float x[8]; unpack8(vr[h][q], x);
#pragma unroll
              for (int e = 0; e < 8; ++e) { sm += x[e]; sq += x[e] * x[e]; } }
      PART[eb * 128 + j] = (f32x2){sm, sq}; }
    __syncthreads();
    float mean, rstd;
    { const f32x2 p0 = PART[j], p1 = PART[128 + j], p2 = PART[256 + j], p3 = PART[384 + j];
      mean = ((p0[0] + p1[0]) + (p2[0] + p3[0])) * (1.f / 1024.f);
      const float var = fmaxf(((p0[1] + p1[1]) + (p2[1] + p3[1])) * (1.f / 1024.f) - mean * mean, 0.f); rstd = rsqrtf(var + EPS); }
#pragma unroll 1
    for (int h = 0; h < 8; ++h) {
        bf16_t* up = P + (R0 + c.wave * 16 + c.fr) * EV_PITCH + h * 128 + 4 * c.fq; u32x2 uw8[8];
#pragma unroll
        for (int t = 0; t < 8; ++t) uw8[t] = *(const u32x2*)(up + 16 * t);
#pragma unroll
        for (int q = 0; q < 4; ++q) { float x[8]; unpack8(vr[0][q], x);
#pragma unroll
            for (int e = 0; e < 8; ++e) Vt[(eb * 32 + 8 * q + e) * 136 + j] = (bf16_t)f2bf((x[e] - mean) * rstd); }
#pragma unroll
        for (int hh = 0; hh < 7; ++hh)
#pragma unroll
            for (int q = 0; q < 4; ++q) vr[hh][q] = vr[hh + 1][q];
#pragma unroll
        for (int q = 0; q < 4; ++q) *(LAS u32x4*)(Wm + wi * 136 + wjs + 8 * q) = wreg[q];
        const float rsi = rsw[h * 128 + c.wave * 16 + c.fr];
        if (h < 7) {
#pragma unroll
            for (int q = 0; q < 4; ++q) wreg[q] = *(const u32x4*)(wmb + (size_t)(h + 1) * 16384 + (size_t)wi * 128 + wjs + 8 * q); }
        __syncthreads();
        f32x4 acc[8];
#pragma unroll
        for (int t = 0; t < 8; ++t) acc[t] = (f32x4){0.f, 0.f, 0.f, 0.f};
#pragma unroll
        for (int k = 0; k < 4; ++k) { const bf16x8 af = LDS_BF8(Wm + (c.wave * 16 + c.fr) * 136 + k * 32 + c.fq * 8);
#pragma unroll
            for (int t = 0; t < 8; ++t) acc[t] = mfma16(LDS_BF8(Vt + (16 * t + c.fr) * 136 + k * 32 + c.fq * 8), af, acc[t]); }
        { const int i = c.wave * 16 + c.fr; const float bi = bs[h * 128 + i];
#pragma unroll
          for (int t = 0; t < 8; ++t) { const u32x2 uw = uw8[t]; const int e0 = h * 128 + 16 * t + 4 * c.fq;
              const f32x4 gg = *(const LAS f32x4*)(LNG + e0), bb = *(const LAS f32x4*)(LNB + e0);
              const f32x4 gt = gg * acc[t] + bb * rsi + bi; u32x2 o;
              o.x = pk2(bflo(uw.x) * gt[0], bfhi(uw.x) * gt[1]); o.y = pk2(bflo(uw.y) * gt[2], bfhi(uw.y) * gt[3]);
              if (!c.dry) *(u32x2*)(up + 16 * t) = o; } }
        __syncthreads();
    }
}
__device__ __forceinline__ void gmlp_sample_unit(const Ctx& c, int b) {
    const ArgsView a{{c.tab}}; bf16_t* P = c.BIG; const size_t R = (size_t)MP + 4 * b; const int c0 = 2 * c.tid, h = c0 >> 7;
    LAS float* RED = (LAS float*)c.lds;
    float v[4][2];
#pragma unroll
    for (int i = 0; i < 4; ++i) { const unsigned w = *(const unsigned*)(P + (R + i) * EV_PITCH + 2048 + c0); v[i][0] = bflo(w); v[i][1] = bfhi(w); }
#pragma unroll
    for (int i = 0; i < 4; ++i) { const float s = wave_sum(v[i][0] + v[i][1]), q = wave_sum(v[i][0] * v[i][0] + v[i][1] * v[i][1]);
        if (c.lane == 0) { RED[c.wave * 8 + i] = s; RED[c.wave * 8 + 4 + i] = q; } }
    __syncthreads();
    float vn[4][2];
#pragma unroll
    for (int i = 0; i < 4; ++i) { float s = 0.f, q = 0.f;
#pragma unroll
        for (int w = 0; w < 8; ++w) { s += RED[w * 8 + i]; q += RED[w * 8 + 4 + i]; }
        const float mean = s * (1.f / 1024.f), rstd = rsqrtf(fmaxf(q * (1.f / 1024.f) - mean * mean, 0.f) + EPS);
#pragma unroll
        for (int e = 0; e < 2; ++e) vn[i][e] = (v[i][e] - mean) * rstd * a.in[I_ALNG][c0 + e] + a.in[I_ALNB][c0 + e];
        *(f32x2*)(c.out + O_AV + ((size_t)b * 4 + i) * 1024 + c0) = (f32x2){vn[i][0], vn[i][1]}; }
#pragma unroll
    for (int i = 0; i < 4; ++i) { float g0 = a.in[I_ABS][h * 128 + i], g1 = g0;
#pragma unroll
        for (int j = 0; j <= i; ++j) { const float w = a.in[I_AWS][(size_t)h * 16384 + i * 128 + j]; g0 += w * vn[j][0]; g1 += w * vn[j][1]; }
        unsigned* up = (unsigned*)(P + (R + i) * EV_PITCH + c0); const unsigned uw = *up; if (!c.dry) *up = pk2(bflo(uw) * g0, bfhi(uw) * g1); }
    __syncthreads();
}

__device__ __forceinline__ void conv8(const bf16_t* P, size_t row, int pos, int cc, const float* cw, const float* cb, float (&o)[8]) {
    { const f32x4 b0 = *(const f32x4*)(cb + cc), b1 = *(const f32x4*)(cb + cc + 4);
#pragma unroll
      for (int e = 0; e < 8; ++e) o[e] = e < 4 ? b0[e & 3] : b1[e & 3]; }
#pragma unroll
    for (int tap = 0; tap < 4; ++tap) {
        if (pos - 3 + tap >= 0) { float x[8]; unpack8(*(const u32x4*)(P + (row - 3 + tap) * EV_PITCH + 3072 + cc), x);
            const f32x4 w0 = *(const f32x4*)(cw + tap * 1536 + cc), w1 = *(const f32x4*)(cw + tap * 1536 + cc + 4);
#pragma unroll
            for (int e = 0; e < 8; ++e) o[e] += (e < 4 ? w0[e & 3] : w1[e & 3]) * x[e]; }
    }
#pragma unroll
    for (int e = 0; e < 8; ++e) o[e] = silu_f(o[e]);
}
__device__ __forceinline__ void conv_load(const bf16_t* P, size_t row, int pos, int cc, u32x4 (&raw)[4]) {
#pragma unroll
    for (int tap = 0; tap < 4; ++tap) raw[tap] = (pos - 3 + tap >= 0) ? *(const u32x4*)(P + (row - 3 + tap) * EV_PITCH + 3072 + cc) : (u32x4){0u, 0u, 0u, 0u};
}
__device__ __forceinline__ void conv_fin(const u32x4 (&raw)[4], int cc, const float* cw, const float* cb, float (&o)[8]) {
    { const f32x4 b0 = *(const f32x4*)(cb + cc), b1 = *(const f32x4*)(cb + cc + 4);
#pragma unroll
      for (int e = 0; e < 8; ++e) o[e] = e < 4 ? b0[e & 3] : b1[e & 3]; }
#pragma unroll
    for (int tap = 0; tap < 4; ++tap) { float x[8]; unpack8(raw[tap], x);
        const f32x4 w0 = *(const f32x4*)(cw + tap * 1536 + cc), w1 = *(const f32x4*)(cw + tap * 1536 + cc + 4);
#pragma unroll
        for (int e = 0; e < 8; ++e) o[e] += (e < 4 ? w0[e & 3] : w1[e & 3]) * x[e]; }
#pragma unroll
    for (int e = 0; e < 8; ++e) o[e] = silu_f(o[e]);
}
__device__ __forceinline__ float ssd_dt_acum(const Ctx& c, size_t R0, int g, LAS float* ACUM, LAS float* DTV) {
    const ArgsView a{{c.tab}}; const int h = 8 * g + c.wave; const float bias = a.in[I_DTB][h], A = -__expf(a.in[I_ALOG][h]); const int j0 = 2 * c.lane;
    const float d0 = softplus_f(c.DT[(R0 + j0) * 16 + h] + bias), d1 = softplus_f(c.DT[(R0 + j0 + 1) * 16 + h] + bias);
    const float a0 = d0 * A, a1 = d1 * A, s = a0 + a1; float inc = s;
#pragma unroll
    for (int o = 1; o < 64; o <<= 1) { const float t = __shfl_up(inc, o); if (c.lane >= o) inc += t; }
    const float excl = inc - s;
    ACUM[c.wave * 128 + j0] = excl + a0; ACUM[c.wave * 128 + j0 + 1] = inc; DTV[c.wave * 128 + j0] = d0; DTV[c.wave * 128 + j0 + 1] = d1;
    return inc;
}
__device__ __forceinline__ void ssd_s1_unit(const Ctx& c, int unit) {
    const ArgsView a{{c.tab}}; const bf16_t* P = c.BIG; const int g = unit & 1, bc = unit >> 1, pos0 = (bc & 31) * 128; const size_t R0 = (size_t)bc * 128;
    LAS float* ACUM = (LAS float*)c.lds; LAS float* DTV = (LAS float*)(c.lds + 4096);
    LAS bf16_t* Bt = (LAS bf16_t*)(c.lds + 8192); LAS bf16_t* XT = (LAS bf16_t*)(c.lds + 43008);
    const float* cw = a.in[I_CONVW]; const float* cb = a.in[I_CONVB];
    const float tot = ssd_dt_acum(c, R0, g, ACUM, DTV);
    if (c.lane == 63) c.CDEC[bc * 16 + 8 * g + c.wave] = __expf(tot);
    { const int j = c.tid & 127, nb = c.tid >> 7; u32x4 raw[4][4];
#pragma unroll
      for (int q = 0; q < 4; ++q) conv_load(P, R0 + j, pos0 + j, 1024 + 128 * g + nb * 32 + 8 * q, raw[q]);
#pragma unroll
      for (int q = 0; q < 4; ++q) { float o[8]; conv_fin(raw[q], 1024 + 128 * g + nb * 32 + 8 * q, cw, cb, o);
#pragma unroll
          for (int e = 0; e < 8; ++e) Bt[(nb * 32 + 8 * q + e) * 136 + j] = (bf16_t)f2bf(o[e]); } }
    __syncthreads();
    bf16_t* ST = (bf16_t*)c.out;
    bf16_t* XC = (bf16_t*)c.out + (size_t)33554432;
    for (int pass = 0; pass < 2; ++pass) {
        { const int j = c.tid & 127, hl = c.tid >> 7, h8 = pass * 4 + hl; const float w = DTV[h8 * 128 + j] * __expf(ACUM[h8 * 128 + 127] - ACUM[h8 * 128 + j]);
          u32x4 raw[8][4];
#pragma unroll
          for (int q = 0; q < 8; ++q) conv_load(P, R0 + j, pos0 + j, (8 * g + h8) * 64 + 8 * q, raw[q]);
#pragma unroll
          for (int q = 0; q < 8; ++q) { float o[8]; conv_fin(raw[q], (8 * g + h8) * 64 + 8 * q, cw, cb, o);
              *(u32x4*)(XC + (R0 + j) * 1024 + (8 * g + h8) * 64 + 8 * q) = pack8(o);
#pragma unroll
              for (int e = 0; e < 8; ++e) XT[(hl * 64 + 8 * q + e) * 136 + j] = (bf16_t)f2bf(o[e] * w); } }
        __syncthreads();
        { const int hl = c.wave >> 1, nh = c.wave & 1; f32x4 acc[4][4];
#pragma unroll
          for (int x = 0; x < 4; ++x)
#pragma unroll
              for (int y = 0; y < 4; ++y) acc[x][y] = (f32x4){0.f, 0.f, 0.f, 0.f};
#pragma unroll
          for (int k = 0; k < 4; ++k) { bf16x8 af[4];
#pragma unroll
              for (int tp = 0; tp < 4; ++tp) af[tp] = LDS_BF8(XT + (hl * 64 + 16 * tp + c.fr) * 136 + k * 32 + c.fq * 8);
#pragma unroll
              for (int tn = 0; tn < 4; ++tn) { const bf16x8 bf = LDS_BF8(Bt + (nh * 64 + 16 * tn + c.fr) * 136 + k * 32 + c.fq * 8);
#pragma unroll
                  for (int tp = 0; tp < 4; ++tp) acc[tp][tn] = mfma16(bf, af[tp], acc[tp][tn]); } }
          const int h = 8 * g + pass * 4 + hl; bf16_t* st = ST + ((size_t)bc * 16 + h) * 8192;
#pragma unroll
          for (int tp = 0; tp < 4; ++tp)
#pragma unroll
              for (int tn = 0; tn < 4; ++tn) { u32x2 o; o.x = pk2(acc[tp][tn][0], acc[tp][tn][1]); o.y = pk2(acc[tp][tn][2], acc[tp][tn][3]);
                  *(u32x2*)(st + (16 * tp + c.fr) * 128 + nh * 64 + 16 * tn + 4 * c.fq) = o; } }
        __syncthreads();
    }
}
__device__ __forceinline__ void ssd_scan_unit(const Ctx& c, int unit) {
    const int t = unit * 512 + c.tid, b = t >> 16, rem = t & 65535, h = rem >> 12;
    unsigned* stA = (unsigned*)c.out + (size_t)b * 32 * 65536 + rem;
    unsigned* stB = stA + (size_t)4 * 32 * 65536;
    float a0 = 0.f, a1 = 0.f, b0 = 0.f, b1 = 0.f;
#pragma unroll 8
    for (int ch = 0; ch < 32; ++ch) {
        const unsigned va = stA[(size_t)ch * 65536], vb = stB[(size_t)ch * 65536];
        const float da = c.CDEC[(b * 32 + ch) * 16 + h], db = c.CDEC[((b + 4) * 32 + ch) * 16 + h];
        if (!c.dry) { stA[(size_t)ch * 65536] = pk2(a0, a1); stB[(size_t)ch * 65536] = pk2(b0, b1); }
        a0 = a0 * da + bflo(va); a1 = a1 * da + bfhi(va); b0 = b0 * db + bflo(vb); b1 = b1 * db + bfhi(vb); }
    if (!c.dry) { *(f32x2*)(c.out + O_SSM_P + (size_t)b * 131072 + (size_t)rem * 2) = (f32x2){a0, a1};
                  *(f32x2*)(c.out + O_SSM_P + (size_t)(b + 4) * 131072 + (size_t)rem * 2) = (f32x2){b0, b1}; }
}
__device__ __forceinline__ void ssd_s3_unit(const Ctx& c, int unit) {
    const ArgsView a{{c.tab}}; bf16_t* P = c.BIG; const int g = unit & 1, bc = unit >> 1, pos0 = (bc & 31) * 128; const size_t R0 = (size_t)bc * 128;
    LAS float* ACUM = (LAS float*)c.lds; LAS float* DTV = (LAS float*)(c.lds + 4096);
    LAS bf16_t* CM = (LAS bf16_t*)(c.lds + 8192); LAS bf16_t* BMm = (LAS bf16_t*)(c.lds + 43008);
    LAS bf16_t* XT = (LAS bf16_t*)(c.lds + 43008); LAS bf16_t* PREV = (LAS bf16_t*)(c.lds + 60416);
    LAS bf16_t* MSW = (LAS bf16_t*)(c.lds + 77824 + c.wave * 4352);
    const float* cw = a.in[I_CONVW]; const float* cb = a.in[I_CONVB]; const int w = c.wave;
    (void)ssd_dt_acum(c, R0, g, ACUM, DTV);
    { const int j = c.tid >> 2, ns = (c.tid & 3) * 32;
#pragma unroll
      for (int bc2 = 0; bc2 < 2; ++bc2) { u32x4 rb[4][4]; const int cc0 = (bc2 ? 1280 : 1024) + 128 * g + ns; LAS bf16_t* dst = bc2 ? CM : BMm;
#pragma unroll
          for (int q = 0; q < 4; ++q) conv_load(P, R0 + j, pos0 + j, cc0 + 8 * q, rb[q]);
#pragma unroll
          for (int q = 0; q < 4; ++q) { float o[8]; conv_fin(rb[q], cc0 + 8 * q, cw, cb, o); *(LAS u32x4*)(dst + j * 136 + ns + 8 * q) = pack8(o); } } }
    __syncthreads();
    f32x4 cbv[8];
#pragma unroll
    for (int t = 0; t < 8; ++t) cbv[t] = (f32x4){0.f, 0.f, 0.f, 0.f};
#pragma unroll
    for (int k = 0; k < 4; ++k) { const bf16x8 af = LDS_BF8(CM + (16 * w + c.fr) * 136 + k * 32 + c.fq * 8);
#pragma unroll
        for (int t = 0; t < 8; ++t) if (t <= w) cbv[t] = mfma16(LDS_BF8(BMm + (16 * t + c.fr) * 136 + k * 32 + c.fq * 8), af, cbv[t]); }
    __syncthreads();
    float ssq = 0.f;
    const bf16_t* ST = (const bf16_t*)c.out;
    const int xj = c.tid & 127, xpb = c.tid >> 7, pvp = c.tid >> 3, pvseg = (c.tid & 7) * 16;
    const bf16_t* XC = (const bf16_t*)c.out + (size_t)33554432;
    u32x4 raw[2], pv0, pv1; u32x2 zn[4];
    { const int h = 8 * g;
#pragma unroll
      for (int q = 0; q < 2; ++q) raw[q] = *(const u32x4*)(XC + (R0 + xj) * 1024 + h * 64 + xpb * 16 + 8 * q);
      const bf16_t* sp = ST + ((size_t)bc * 16 + h) * 8192 + pvp * 128 + pvseg; pv0 = *(const u32x4*)sp; pv1 = *(const u32x4*)(sp + 8);
      const bf16_t* zq = P + (R0 + 16 * w + c.fr) * EV_PITCH + 1024 + h * 64 + 4 * c.fq;
#pragma unroll
      for (int t = 0; t < 4; ++t) zn[t] = *(const u32x2*)(zq + 16 * t); }
    for (int h8 = 0; h8 < 8; ++h8) {
        const int h = 8 * g + h8; const float dsk = a.in[I_DSKIP][h];
        bf16_t* zp = P + (R0 + 16 * w + c.fr) * EV_PITCH + 1024 + h * 64 + 4 * c.fq;
#pragma unroll
        for (int q = 0; q < 2; ++q) { const u32x4 rv = raw[q];
            XT[(xpb * 16 + 8 * q + 0) * 136 + xj] = (bf16_t)(rv.x & 0xffffu); XT[(xpb * 16 + 8 * q + 1) * 136 + xj] = (bf16_t)(rv.x >> 16);
            XT[(xpb * 16 + 8 * q + 2) * 136 + xj] = (bf16_t)(rv.y & 0xffffu); XT[(xpb * 16 + 8 * q + 3) * 136 + xj] = (bf16_t)(rv.y >> 16);
            XT[(xpb * 16 + 8 * q + 4) * 136 + xj] = (bf16_t)(rv.z & 0xffffu); XT[(xpb * 16 + 8 * q + 5) * 136 + xj] = (bf16_t)(rv.z >> 16);
            XT[(xpb * 16 + 8 * q + 6) * 136 + xj] = (bf16_t)(rv.w & 0xffffu); XT[(xpb * 16 + 8 * q + 7) * 136 + xj] = (bf16_t)(rv.w >> 16); }
        *(LAS u32x4*)(PREV + pvp * 136 + pvseg) = pv0; *(LAS u32x4*)(PREV + pvp * 136 + pvseg + 8) = pv1;
        if (h8 < 7) { const int hn = h + 1;
#pragma unroll
            for (int q = 0; q < 2; ++q) raw[q] = *(const u32x4*)(XC + (R0 + xj) * 1024 + hn * 64 + xpb * 16 + 8 * q);
            const bf16_t* sp = ST + ((size_t)bc * 16 + hn) * 8192 + pvp * 128 + pvseg; pv0 = *(const u32x4*)sp; pv1 = *(const u32x4*)(sp + 8); }
        { const int i = 16 * w + c.fr; const float ai = ACUM[h8 * 128 + i];
#pragma unroll
          for (int t = 0; t < 8; ++t) { const int j0 = 16 * t + 4 * c.fq; float v[4] = {0.f, 0.f, 0.f, 0.f};
              if (t <= w) { const f32x4 aj = *(const LAS f32x4*)(ACUM + h8 * 128 + j0), dj = *(const LAS f32x4*)(DTV + h8 * 128 + j0);
#pragma unroll
                  for (int jj = 0; jj < 4; ++jj) if (j0 + jj <= i) v[jj] = cbv[t][jj] * __expf(ai - aj[jj]) * dj[jj]; }
              u32x2 o; o.x = pk2(v[0], v[1]); o.y = pk2(v[2], v[3]); *(LAS u32x2*)(MSW + c.fr * 136 + j0) = o; } }
        __syncthreads();
        f32x4 yd[4], yo[4];
#pragma unroll
        for (int t = 0; t < 4; ++t) { yd[t] = (f32x4){0.f, 0.f, 0.f, 0.f}; yo[t] = (f32x4){0.f, 0.f, 0.f, 0.f}; }
#pragma unroll
        for (int k = 0; k < 4; ++k) { const bf16x8 am = LDS_BF8(MSW + c.fr * 136 + k * 32 + c.fq * 8), ac = LDS_BF8(CM + (16 * w + c.fr) * 136 + k * 32 + c.fq * 8);
#pragma unroll
            for (int t = 0; t < 4; ++t) { yd[t] = mfma16(LDS_BF8(XT + (16 * t + c.fr) * 136 + k * 32 + c.fq * 8), am, yd[t]);
                yo[t] = mfma16(LDS_BF8(PREV + (16 * t + c.fr) * 136 + k * 32 + c.fq * 8), ac, yo[t]); } }
        { const int i = 16 * w + c.fr; const float ei = __expf(ACUM[h8 * 128 + i]);
#pragma unroll
          for (int t = 0; t < 4; ++t) { const u32x2 zw_ = zn[t]; float y[4];
#pragma unroll
              for (int jj = 0; jj < 4; ++jj) { const int p = 16 * t + 4 * c.fq + jj; y[jj] = yd[t][jj] + ei * yo[t][jj] + dsk * bf2f(XT[p * 136 + i]); }
              y[0] *= silu_f(bflo(zw_.x)); y[1] *= silu_f(bfhi(zw_.x)); y[2] *= silu_f(bflo(zw_.y)); y[3] *= silu_f(bfhi(zw_.y));
              ssq += (y[0] * y[0] + y[1] * y[1]) + (y[2] * y[2] + y[3] * y[3]);
              u32x2 o; o.x = pk2(y[0], y[1]); o.y = pk2(y[2], y[3]); if (!c.dry) *(u32x2*)(zp + 16 * t) = o; } }
        if (h8 < 7) {
#pragma unroll
            for (int t = 0; t < 4; ++t) zn[t] = *(const u32x2*)(zp + 64 + 16 * t); }
        __syncthreads();
    }
    { float sq = ssq; sq += __shfl_xor(sq, 16); sq += __shfl_xor(sq, 32);
      const float r = rsqrtf(sq * (1.f / 512.f) + EPS); const int i = 16 * w + c.fr;
      bf16_t* zp = P + (R0 + i) * EV_PITCH + 1024 + 8 * g * 64 + 4 * c.fq;
#pragma unroll
      for (int q = 0; q < 32; ++q) { const u32x2 v = *(const u32x2*)(zp + 16 * q); u32x2 o; o.x = pk2(bflo(v.x) * r, bfhi(v.x) * r); o.y = pk2(bflo(v.y) * r, bfhi(v.y) * r);
          if (!c.dry) *(u32x2*)(zp + 16 * q) = o; } }
}
__device__ __forceinline__ void ssd_sample_unit(const Ctx& c, int unit) {
    const ArgsView a{{c.tab}}; bf16_t* P = c.BIG; const int b = unit >> 1, g = unit & 1; const size_t R = (size_t)MP + 4 * b;
    LAS float* XS = (LAS float*)c.lds; LAS float* BS = (LAS float*)(c.lds + 8192); LAS float* CS = (LAS float*)(c.lds + 10240);
    LAS float* DTs = (LAS float*)(c.lds + 12288); LAS float* ACs = (LAS float*)(c.lds + 12416); LAS float* SSQ = (LAS float*)(c.lds + 12544);
    const float* cw = a.in[I_CONVW]; const float* cb = a.in[I_CONVB]; const float* sc = a.in[I_CONV];
    for (int idx = c.tid; idx < 768; idx += 512) {
        int col, stride; LAS float* dst;
        if (idx < 512) { col = g * 512 + idx; dst = XS + idx; stride = 512; } else if (idx < 640) { col = 1024 + 128 * g + (idx - 512); dst = BS + (idx - 512); stride = 128; }
        else { col = 1280 + 128 * g + (idx - 640); dst = CS + (idx - 640); stride = 128; }
        float e[7];
#pragma unroll
        for (int r = 0; r < 3; ++r) e[r] = sc[((size_t)b * 3 + r) * 1536 + col];
#pragma unroll
        for (int i = 0; i < 4; ++i) e[3 + i] = bf2f(P[(R + i) * EV_PITCH + 3072 + col]);
#pragma unroll
        for (int i = 0; i < 4; ++i) { float o = cb[col];
#pragma unroll
            for (int tap = 0; tap < 4; ++tap) o += cw[tap * 1536 + col] * e[i + tap];
            dst[i * stride] = silu_f(o); }
    }
    if (g == 0) for (int idx = c.tid; idx < 3 * 1536; idx += 512) { const int r = idx / 1536, col = idx % 1536;
        c.out[O_CONV_S + ((size_t)b * 3 + r) * 1536 + col] = bf2f(P[(R + r + 1) * EV_PITCH + 3072 + col]); }
    if (c.tid < 8) { const int h = 8 * g + c.tid; const float bias = a.in[I_DTB][h], A = -__expf(a.in[I_ALOG][h]); float acc = 0.f;
#pragma unroll
        for (int i = 0; i < 4; ++i) { const float d = softplus_f(c.DT[(R + i) * 16 + h] + bias); acc += d * A; DTs[i * 8 + c.tid] = d; ACs[i * 8 + c.tid] = acc; } }
    __syncthreads();
    const int h = 8 * g + c.wave; const float dsk = a.in[I_DSKIP][h];
    float dt[4], ac[4];
#pragma unroll
    for (int i = 0; i < 4; ++i) { dt[i] = DTs[i * 8 + c.wave]; ac[i] = ACs[i * 8 + c.wave]; }
    float cbm[4][4];
    { const int n0 = 2 * c.lane; float Bv[4][2], Cv[4][2];
#pragma unroll
      for (int i = 0; i < 4; ++i) { Bv[i][0] = BS[i * 128 + n0]; Bv[i][1] = BS[i * 128 + n0 + 1]; Cv[i][0] = CS[i * 128 + n0]; Cv[i][1] = CS[i * 128 + n0 + 1]; }
#pragma unroll
      for (int i = 0; i < 4; ++i)
#pragma unroll
          for (int j = 0; j < 4; ++j) { if (j <= i) { const float v = wave_sum(Cv[i][0] * Bv[j][0] + Cv[i][1] * Bv[j][1]); cbm[i][j] = v * __expf(ac[i] - ac[j]) * dt[j]; } else cbm[i][j] = 0.f; } }
    const float e3 = __expf(ac[3]);
    const int p = c.lane; float xv[4], wx[4];
#pragma unroll
    for (int j = 0; j < 4; ++j) { xv[j] = XS[j * 512 + c.wave * 64 + p]; wx[j] = __expf(ac[3] - ac[j]) * dt[j] * xv[j]; }
    const float* s0p = a.in[I_SSM] + ((size_t)b * 16 + h) * 8192 + (size_t)p * 128; float* sout = c.out + O_SSM_S + ((size_t)b * 16 + h) * 8192 + (size_t)p * 128;
    float yo[4] = {0.f, 0.f, 0.f, 0.f};
#pragma unroll 1
    for (int blk = 0; blk < 4; ++blk) {
        f32x4 sv[8];
#pragma unroll
        for (int q = 0; q < 8; ++q) sv[q] = *(const f32x4*)(s0p + blk * 32 + 4 * q);
#pragma unroll
        for (int q = 0; q < 8; ++q) { const int n = blk * 32 + 4 * q; f32x4 ns = sv[q] * e3;
#pragma unroll
            for (int j = 0; j < 4; ++j) { const f32x4 bq = *(const LAS f32x4*)(BS + j * 128 + n), cq = *(const LAS f32x4*)(CS + j * 128 + n);
                ns = ns + bq * wx[j]; yo[j] += (cq[0] * sv[q][0] + cq[1] * sv[q][1]) + (cq[2] * sv[q][2] + cq[3] * sv[q][3]); }
            *(f32x4*)(sout + n) = ns; }
    }
    float ym[4];
#pragma unroll
    for (int i = 0; i < 4; ++i) { float y = __expf(ac[i]) * yo[i] + dsk * xv[i];
#pragma unroll
        for (int j = 0; j < 4; ++j) y += cbm[i][j] * xv[j];
        ym[i] = y; }
#pragma unroll
    for (int i = 0; i < 4; ++i) { const float z = bf2f(P[(R + i) * EV_PITCH + 1024 + h * 64 + c.lane]); ym[i] *= silu_f(z); const float ss = wave_sum(ym[i] * ym[i]); if (c.lane == 0) SSQ[c.wave * 4 + i] = ss; }
    __syncthreads();
#pragma unroll
    for (int i = 0; i < 4; ++i) { float tot = 0.f;
#pragma unroll
        for (int w = 0; w < 8; ++w) tot += SSQ[w * 4 + i];
        if (!c.dry) P[(R + i) * EV_PITCH + 1024 + h * 64 + c.lane] = (bf16_t)f2bf(ym[i] * rsqrtf(tot * (1.f / 512.f) + EPS)); }
    __syncthreads();
}

__device__ __forceinline__ void pool_unit(const Ctx& c, int unit) {
    const ArgsView a{{c.tab}}; bf16_t* P = c.BIG; const int gi = unit & 3, rt = unit >> 2, win = 2 << gi; const size_t T0 = (size_t)rt * 128;
    LAS bf16_t* RAW = (LAS bf16_t*)c.lds;
    LAS bf16_t* A = (LAS bf16_t*)(c.lds + 75520);
    const float* sp = a.in[I_POOL];
    const bf16_t* LW = (const bf16_t*)(c.ws + WS_CLIN) + (size_t)gi * 65536;
    if (rt < 256) {
        const int posb = (int)(T0 & 4095);
        u32x4 rv[9];
#pragma unroll
        for (int i = 0; i < 9; ++i) { const int idx = c.tid + 512 * i, rr = idx >> 5, cq = idx & 31; rv[i] = (u32x4){0u, 0u, 0u, 0u};
            if (idx < 143 * 32 && posb - 15 + rr >= 0) rv[i] = *(const u32x4*)(P + (T0 - 15 + rr) * OD_PITCH + OD_N + gi * 256 + cq * 8); }
#pragma unroll
        for (int i = 0; i < 9; ++i) { const int idx = c.tid + 512 * i, rr = idx >> 5, cq = idx & 31; if (idx < 143 * 32) *(LAS u32x4*)(RAW + rr * 264 + cq * 8) = rv[i]; }
        __syncthreads();
        const int cp = c.tid & 127, l0 = (c.tid >> 7) * 32; float s0 = 0.f, s1 = 0.f;
        for (int k = 1; k < win; ++k) { const unsigned w = *(const LAS unsigned*)(RAW + (15 + l0 - k) * 264 + 2 * cp); s0 += bflo(w); s1 += bfhi(w); }
#pragma unroll 4
        for (int l = l0; l < l0 + 32; ++l) { const unsigned w = *(const LAS unsigned*)(RAW + (15 + l) * 264 + 2 * cp); const float c0 = bflo(w), c1 = bfhi(w);
            s0 += c0; s1 += c1; const float ic = 1.f / (float)min(posb + l + 1, win);
            *(LAS unsigned*)(A + l * 264 + 2 * cp) = pk2(s0 * ic - c0, s1 * ic - c1);
            const unsigned o = *(const LAS unsigned*)(RAW + (15 + l - win + 1) * 264 + 2 * cp); s0 -= bflo(o); s1 -= bfhi(o); }
    } else {
        const float ic = 1.f / (float)win; const int b0 = (int)((T0 - MP) >> 2);
        for (int it = c.tid; it < 2048; it += 512) { const int bl = it >> 6, cq = it & 63, bb = b0 + bl; f32x4 ext[19];
#pragma unroll
            for (int e = 0; e < 15; ++e) ext[e] = *(const f32x4*)(sp + ((size_t)bb * 15 + e) * 1024 + gi * 256 + 4 * cq);
#pragma unroll
            for (int i = 0; i < 4; ++i) { const u32x2 w = *(const u32x2*)(P + ((size_t)MP + 4 * bb + i) * OD_PITCH + OD_N + gi * 256 + 4 * cq); ext[15 + i] = (f32x4){bflo(w.x), bfhi(w.x), bflo(w.y), bfhi(w.y)}; }
#pragma unroll
            for (int i = 0; i < 4; ++i) { f32x4 sm = (f32x4){0.f, 0.f, 0.f, 0.f};
#pragma unroll
                for (int k = 0; k < 16; ++k) if (k < win) sm = sm + ext[15 + i - k];
                const f32x4 o = sm * ic - ext[15 + i]; u32x2 w; w.x = pk2(o[0], o[1]); w.y = pk2(o[2], o[3]);
                *(LAS u32x2*)(A + (4 * bl + i) * 264 + 4 * cq) = w; } }
    }
    LAS bf16_t* Bs = RAW;
    u32x4 breg[8];
#pragma unroll
    for (int i = 0; i < 8; ++i) { const int idx = c.tid + 512 * i; breg[i] = *(const u32x4*)(LW + (size_t)(idx >> 5) * 256 + (idx & 31) * 8); }
    __syncthreads();
    for (int half = 0; half < 2; ++half) {
#pragma unroll
        for (int i = 0; i < 8; ++i) { const int idx = c.tid + 512 * i; *(LAS u32x4*)(Bs + (idx >> 5) * 264 + (idx & 31) * 8) = breg[i]; }
        if (half == 0) {
#pragma unroll
            for (int i = 0; i < 8; ++i) { const int idx = c.tid + 512 * i; breg[i] = *(const u32x4*)(LW + (size_t)(128 + (idx >> 5)) * 256 + (idx & 31) * 8); } }
        __syncthreads();
        f32x4 acc[8];
#pragma unroll
        for (int t = 0; t < 8; ++t) acc[t] = (f32x4){0.f, 0.f, 0.f, 0.f};
#pragma unroll
        for (int k = 0; k < 8; ++k) { const bf16x8 af = LDS_BF8(A + (16 * c.wave + c.fr) * 264 + k * 32 + c.fq * 8);
#pragma unroll
            for (int t = 0; t < 8; ++t) acc[t] = mfma16(LDS_BF8(Bs + (16 * t + c.fr) * 264 + k * 32 + c.fq * 8), af, acc[t]); }
        { bf16_t* op = P + (T0 + 16 * c.wave + c.fr) * OD_PITCH + gi * 256 + half * 128 + 4 * c.fq;
#pragma unroll
          for (int t = 0; t < 8; ++t) { u32x2 o; o.x = pk2(acc[t][0], acc[t][1]); o.y = pk2(acc[t][2], acc[t][3]); *(u32x2*)(op + 16 * t) = o; } }
        __syncthreads();
    }
}

template <int NST, int NKS, int VP, int PP, bool PRE>
__device__ __forceinline__ void attn_core(bf16x8 q0, bf16x8 q1, LAS const bf16_t* Ks, LAS const bf16_t* Vt, LAS const float* BIASl, LAS bf16_t* PS, int t0,
                                          int dbase, int gsel, float sink, int kmin, int kmax, int fr, int fq, f32x4 (&o)[4], const f32x4 (&bm)[NST]) {
    f32x4 s[NST];
#pragma unroll
    for (int t = 0; t < NST; ++t) { s[t] = (f32x4){0.f, 0.f, 0.f, 0.f};
        s[t] = mfma16(LDS_BF8(Ks + (16 * (t0 + t) + fr) * 72 + fq * 8), q0, s[t]); s[t] = mfma16(LDS_BF8(Ks + (16 * (t0 + t) + fr) * 72 + 32 + fq * 8), q1, s[t]); }
    float mx = sink;
#pragma unroll
    for (int t = 0; t < NST; ++t)
#pragma unroll
        for (int jj = 0; jj < 4; ++jj) { float v;
            if (PRE) { v = s[t][jj] + bm[t][jj]; if (16 * (t0 + t) + 4 * fq + jj < kmin) v = -1e30f; v = fmaxf(v, -1e30f); }
            else { const int kk = 16 * (t0 + t) + 4 * fq + jj, d = dbase - kk; const bool valid = d >= 0 && d < 128 && kk >= kmin && kk < kmax;
                v = valid ? s[t][jj] + BIASl[gsel * 128 + (d & 127)] : -1e30f; }
            s[t][jj] = v; mx = fmaxf(mx, v); }
    mx = fmaxf(mx, __shfl_xor(mx, 16)); mx = fmaxf(mx, __shfl_xor(mx, 32));
    float sum = 0.f;
#pragma unroll
    for (int t = 0; t < NST; ++t) { float p[4];
#pragma unroll
        for (int jj = 0; jj < 4; ++jj) { p[jj] = __expf(s[t][jj] - mx); sum += p[jj]; }
        u32x2 w; w.x = pk2(p[0], p[1]); w.y = pk2(p[2], p[3]); *(LAS u32x2*)(PS + fr * PP + 16 * t + 4 * fq) = w; }
#pragma unroll
    for (int t = NST; t < 2 * NKS; ++t) *(LAS u32x2*)(PS + fr * PP + 16 * t + 4 * fq) = (u32x2){0u, 0u};
    sum += __shfl_xor(sum, 16); sum += __shfl_xor(sum, 32);
    const float inv = 1.f / (sum + __expf(sink - mx));
#pragma unroll
    for (int td = 0; td < 4; ++td) o[td] = (f32x4){0.f, 0.f, 0.f, 0.f};
#pragma unroll
    for (int k = 0; k < NKS; ++k) { const bf16x8 pa = LDS_BF8(PS + fr * PP + k * 32 + fq * 8);
#pragma unroll
        for (int td = 0; td < 4; ++td) o[td] = mfma16(LDS_BF8(Vt + (16 * td + fr) * VP + 16 * t0 + k * 32 + fq * 8), pa, o[td]); }
#pragma unroll
    for (int td = 0; td < 4; ++td) o[td] = o[td] * inv;
}
__device__ __forceinline__ void load_q(const bf16_t* qp, const float* qn, int fq, bf16x8& q0, bf16x8& q1) {
    float x[8], y[8]; unpack8(*(const u32x4*)(qp + fq * 8), x); unpack8(*(const u32x4*)(qp + 32 + fq * 8), y);
    float ss = 0.f;
#pragma unroll
    for (int e = 0; e < 8; ++e) ss += x[e] * x[e] + y[e] * y[e];
    ss += __shfl_xor(ss, 16); ss += __shfl_xor(ss, 32);
    const float rs = rsqrtf(ss * (1.f / 64.f) + EPS) * 0.125f;
#pragma unroll
    for (int e = 0; e < 8; ++e) { x[e] *= rs * qn[fq * 8 + e]; y[e] *= rs * qn[32 + fq * 8 + e]; }
    const u32x4 a = pack8(x), b = pack8(y); q0 = __builtin_bit_cast(bf16x8, a); q1 = __builtin_bit_cast(bf16x8, b);
}
__device__ __forceinline__ void attn_prompt_unit(const Ctx& c, int unit) {
    const ArgsView a{{c.tab}}; bf16_t* P = c.BIG; const int hk = unit & 3, bb = unit >> 2, blk = bb & 31, b = bb >> 5; const size_t Q0 = (size_t)bb * 128;
    LAS bf16_t* Ks = (LAS bf16_t*)c.lds; LAS bf16_t* Vt = (LAS bf16_t*)(c.lds + 36864); LAS float* BIASl = (LAS float*)(c.lds + 72704);
    LAS bf16_t* PS = (LAS bf16_t*)(c.lds + 74752 + c.wave * 5376);
    if (c.tid < 64) { *(LAS u32x4*)(Vt + c.tid * 280 + 256) = (u32x4){0u, 0u, 0u, 0u}; *(LAS u32x4*)(Vt + c.tid * 280 + 264) = (u32x4){0u, 0u, 0u, 0u}; }
    { const int kk = c.tid >> 1, half = c.tid & 1; const bool ok = (blk > 0) || kk >= 128; float v[32];
      if (ok) { const bf16_t* kp = P + (Q0 - 128 + kk) * OD_PITCH + 2048 + hk * 64 + half * 32;
#pragma unroll
          for (int q = 0; q < 4; ++q) { float x[8]; unpack8(*(const u32x4*)(kp + 8 * q), x);
#pragma unroll
              for (int e = 0; e < 8; ++e) v[8 * q + e] = x[e]; } }
      else {
#pragma unroll
          for (int e = 0; e < 32; ++e) v[e] = 0.f; }
      float ss = 0.f;
#pragma unroll
      for (int e = 0; e < 32; ++e) ss += v[e] * v[e];
      ss += __shfl_xor(ss, 1); const float rs = rsqrtf(ss * (1.f / 64.f) + EPS);
#pragma unroll
      for (int e = 0; e < 32; ++e) v[e] *= rs * a.in[I_KN][half * 32 + e];
#pragma unroll
      for (int q = 0; q < 4; ++q) { float x[8];
#pragma unroll
          for (int e = 0; e < 8; ++e) x[e] = v[8 * q + e];
          *(LAS u32x4*)(Ks + kk * 72 + half * 32 + 8 * q) = pack8(x); }
      if (blk == 31 && kk >= 128) { float* op = c.out + O_K_P + (((size_t)b * 128 + (kk - 128)) * 4 + hk) * 64 + half * 32;
#pragma unroll
          for (int q = 0; q < 8; ++q) *(f32x4*)(op + 4 * q) = (f32x4){v[4 * q], v[4 * q + 1], v[4 * q + 2], v[4 * q + 3]}; } }
    { const int kk = c.tid & 255, dh = c.tid >> 8; const bool ok = (blk > 0) || kk >= 128; float v[32];
      if (ok) { const bf16_t* vp = P + (Q0 - 128 + kk) * OD_PITCH + 2304 + hk * 64 + dh * 32;
#pragma unroll
          for (int q = 0; q < 4; ++q) { float x[8]; unpack8(*(const u32x4*)(vp + 8 * q), x);
#pragma unroll
              for (int e = 0; e < 8; ++e) v[8 * q + e] = x[e]; } }
      else {
#pragma unroll
          for (int e = 0; e < 32; ++e) v[e] = 0.f; }
#pragma unroll
      for (int e = 0; e < 32; ++e) Vt[(dh * 32 + e) * 280 + kk] = (bf16_t)f2bf(v[e]);
      if (blk == 31 && kk >= 128) { float* op = c.out + O_V_P + (((size_t)b * 128 + (kk - 128)) * 4 + hk) * 64 + dh * 32;
#pragma unroll
          for (int q = 0; q < 8; ++q) *(f32x4*)(op + 4 * q) = (f32x4){v[4 * q], v[4 * q + 1], v[4 * q + 2], v[4 * q + 3]}; } }
    { const int g = c.tid >> 7, d = c.tid & 127; BIASl[c.tid] = a.in[I_REL][(int)T5B[d] * 16 + hk * 4 + g]; }
    __syncthreads();
    const int g = c.wave >> 1, hq = hk * 4 + g, half = c.wave & 1; const float sk = a.in[I_SINKS][hq];
    bf16x8 qa[4], qb[4];
#pragma unroll
    for (int r4 = 0; r4 < 4; ++r4) load_q(P + (Q0 + half * 64 + r4 * 16 + c.fr) * OD_PITCH + 1024 + hq * 64, a.in[I_QN], c.fq, qa[r4], qb[r4]);
    f32x4 bm[9];
#pragma unroll
    for (int t = 0; t < 9; ++t)
#pragma unroll
        for (int jj = 0; jj < 4; ++jj) { const int d = 128 + c.fr - 16 * t - 4 * c.fq - jj; bm[t][jj] = (d >= 0 && d < 128) ? BIASl[g * 128 + (d & 127)] : -2e30f; }
#pragma unroll
    for (int r4 = 0; r4 < 4; ++r4) {
        const int i0 = half * 64 + r4 * 16; const bf16x8 q0 = qa[r4], q1 = qb[r4];
        f32x4 o[4];
        attn_core<9, 5, 280, 168, true>(q0, q1, Ks, Vt, BIASl, PS, i0 >> 4, 128 + i0 + c.fr, g, sk, blk > 0 ? 0 : 128, 256, c.fr, c.fq, o, bm);
        { bf16_t* op = P + (Q0 + i0 + c.fr) * OD_PITCH + 1024 + hq * 64 + 4 * c.fq;
#pragma unroll
          for (int td = 0; td < 4; ++td) { u32x2 w; w.x = pk2(o[td][0], o[td][1]); w.y = pk2(o[td][2], o[td][3]); if (!c.dry) *(u32x2*)(op + 16 * td) = w; } }
    }
    __syncthreads();
}
__device__ __forceinline__ void attn_sample_unit(const Ctx& c, int unit) {
    const ArgsView a{{c.tab}}; bf16_t* P = c.BIG; const int hk = unit & 3, b = unit >> 2; const size_t R = (size_t)MP + 4 * b;
    LAS bf16_t* Ks = (LAS bf16_t*)c.lds; LAS bf16_t* Vt = (LAS bf16_t*)(c.lds + 23040); LAS float* BIASl = (LAS float*)(c.lds + 44544); LAS bf16_t* PS = (LAS bf16_t*)(c.lds + 46592);
    { const int kk = c.tid >> 1, half = c.tid & 1;
      if (kk < 160) { float v[32];
          if (kk < 128) { const float* kp = a.in[I_CK] + (((size_t)b * 128 + kk) * 4 + hk) * 64 + half * 32;
#pragma unroll
              for (int q = 0; q < 8; ++q) { const f32x4 x = *(const f32x4*)(kp + 4 * q); v[4 * q] = x[0]; v[4 * q + 1] = x[1]; v[4 * q + 2] = x[2]; v[4 * q + 3] = x[3]; } }
          else if (kk < 132) { const bf16_t* kp = P + (R + (kk - 128)) * OD_PITCH + 2048 + hk * 64 + half * 32;
#pragma unroll
              for (int q = 0; q < 4; ++q) { float x[8]; unpack8(*(const u32x4*)(kp + 8 * q), x);
#pragma unroll
                  for (int e = 0; e < 8; ++e) v[8 * q + e] = x[e]; } }
          else {
#pragma unroll
              for (int e = 0; e < 32; ++e) v[e] = 0.f; }
          float ss = 0.f;
#pragma unroll
          for (int e = 0; e < 32; ++e) ss += v[e] * v[e];
          ss += __shfl_xor(ss, 1);
          if (kk >= 128) { const float rs = rsqrtf(ss * (1.f / 64.f) + EPS);
#pragma unroll
              for (int e = 0; e < 32; ++e) v[e] *= rs * a.in[I_KN][half * 32 + e]; }
#pragma unroll
          for (int q = 0; q < 4; ++q) { float x[8];
#pragma unroll
              for (int e = 0; e < 8; ++e) x[e] = v[8 * q + e];
              *(LAS u32x4*)(Ks + kk * 72 + half * 32 + 8 * q) = pack8(x); }
          if (kk >= 4 && kk < 132) { float* op = c.out + O_K_S + (((size_t)b * 128 + (kk - 4)) * 4 + hk) * 64 + half * 32;
#pragma unroll
              for (int q = 0; q < 8; ++q) *(f32x4*)(op + 4 * q) = (f32x4){v[4 * q], v[4 * q + 1], v[4 * q + 2], v[4 * q + 3]}; } }
      else { (void)__shfl_xor(0.f, 1); } }
    { const int kk = c.tid & 255, dh = c.tid >> 8;
      if (kk < 160) { float v[32];
          if (kk < 128) { const float* vp = a.in[I_CV] + (((size_t)b * 128 + kk) * 4 + hk) * 64 + dh * 32;
#pragma unroll
              for (int q = 0; q < 8; ++q) { const f32x4 x = *(const f32x4*)(vp + 4 * q); v[4 * q] = x[0]; v[4 * q + 1] = x[1]; v[4 * q + 2] = x[2]; v[4 * q + 3] = x[3]; } }
          else if (kk < 132) { const bf16_t* vp = P + (R + (kk - 128)) * OD_PITCH + 2304 + hk * 64 + dh * 32;
#pragma unroll
              for (int q = 0; q < 4; ++q) { float x[8]; unpack8(*(const u32x4*)(vp + 8 * q), x);
#pragma unroll
                  for (int e = 0; e < 8; ++e) v[8 * q + e] = x[e]; } }
          else {
#pragma unroll
              for (int e = 0; e < 32; ++e) v[e] = 0.f; }
#pragma unroll
          for (int e = 0; e < 32; ++e) Vt[(dh * 32 + e) * 168 + kk] = (bf16_t)f2bf(v[e]);
          if (kk >= 4 && kk < 132) { float* op = c.out + O_V_S + (((size_t)b * 128 + (kk - 4)) * 4 + hk) * 64 + dh * 32;
#pragma unroll
              for (int q = 0; q < 8; ++q) *(f32x4*)(op + 4 * q) = (f32x4){v[4 * q], v[4 * q + 1], v[4 * q + 2], v[4 * q + 3]}; } } }
    { const int g = c.tid >> 7, d = c.tid & 127; BIASl[c.tid] = a.in[I_REL][(int)T5B[d] * 16 + hk * 4 + g]; }
    __syncthreads();
    if (c.wave == 0) {
        bf16x8 q0, q1; const int gq = c.fr >> 2, iq = c.fr & 3;
        load_q(P + (R + iq) * OD_PITCH + 1024 + (hk * 4 + gq) * 64, a.in[I_QN], c.fq, q0, q1);
        f32x4 o[4];
        f32x4 bm0[10]; attn_core<10, 5, 168, 168, false>(q0, q1, Ks, Vt, BIASl, PS, 0, 128 + iq, gq, a.in[I_SINKS][hk * 4 + gq], 0, 132, c.fr, c.fq, o, bm0);
        { bf16_t* op = P + (R + iq) * OD_PITCH + 1024 + (hk * 4 + gq) * 64 + 4 * c.fq;
#pragma unroll
          for (int td = 0; td < 4; ++td) { u32x2 w; w.x = pk2(o[td][0], o[td][1]); w.y = pk2(o[td][2], o[td][3]); if (!c.dry) *(u32x2*)(op + 16 * td) = w; } }
    }
    __syncthreads();
}

template <int KS>
__device__ __forceinline__ void mini_res_gemm(const Ctx& c, const bf16_t* A, int lda, const bf16_t* Bt, float alpha, int G, float* OUT) {
    constexpr int K = KS * 256;
    LAS float* PART = (LAS float*)c.lds;
    for (int it = blockIdx.x; it < 256; it += G) {
        const int r0 = (it >> 4) * 32, c0 = (it & 15) * 64;
        f32x4 acc[2][4];
#pragma unroll
        for (int mi = 0; mi < 2; ++mi)
#pragma unroll
            for (int ni = 0; ni < 4; ++ni) acc[mi][ni] = (f32x4){0.f, 0.f, 0.f, 0.f};
        const bf16_t* ap = A + (size_t)(r0 + c.fr) * lda + c.wave * (KS * 32) + c.fq * 8;
        const bf16_t* bp = Bt + (size_t)(c0 + c.fr) * K + c.wave * (KS * 32) + c.fq * 8;
#pragma unroll
        for (int ks = 0; ks < KS; ++ks) {
            bf16x8 af[2], bf[4];
#pragma unroll
            for (int mi = 0; mi < 2; ++mi) af[mi] = *(const bf16x8*)(ap + (size_t)mi * 16 * lda + ks * 32);
#pragma unroll
            for (int ni = 0; ni < 4; ++ni) bf[ni] = *(const bf16x8*)(bp + (size_t)ni * 16 * K + ks * 32);
#pragma unroll
            for (int mi = 0; mi < 2; ++mi)
#pragma unroll
                for (int ni = 0; ni < 4; ++ni) acc[mi][ni] = mfma16(af[mi], bf[ni], acc[mi][ni]);
        }
#pragma unroll
        for (int mi = 0; mi < 2; ++mi)
#pragma unroll
            for (int ni = 0; ni < 4; ++ni)
#pragma unroll
                for (int j = 0; j < 4; ++j) PART[c.wave * 2048 + (16 * mi + 4 * c.fq + j) * 64 + 16 * ni + c.fr] = acc[mi][ni][j];
        __syncthreads();
        { const int row = c.tid >> 4, cq = c.tid & 15; f32x4 v = (f32x4){0.f, 0.f, 0.f, 0.f};
#pragma unroll
          for (int w = 0; w < 8; ++w) v = v + *(const LAS f32x4*)(PART + w * 2048 + row * 64 + 4 * cq);
          const size_t grow = (size_t)MP + r0 + row; const size_t off = grow * DM + c0 + 4 * cq;
          const u32x2 xw = *(const u32x2*)(c.XB + off); f32x4 h = (f32x4){bflo(xw.x), bfhi(xw.x), bflo(xw.y), bfhi(xw.y)} + v * alpha;
          if (OUT != nullptr) *(f32x4*)(OUT + off) = h;
          else { u32x2 w2; w2.x = pk2(h[0], h[1]); w2.y = pk2(h[2], h[3]); *(u32x2*)(c.XB + off) = w2; }
          float ss = (h[0] * h[0] + h[1] * h[1]) + (h[2] * h[2] + h[3] * h[3]);
          ss += __shfl_xor(ss, 1); ss += __shfl_xor(ss, 2); ss += __shfl_xor(ss, 4); ss += __shfl_xor(ss, 8);
          if (cq == 0) c.RSP[grow * 16 + (it & 15)] = ss; }
        __syncthreads();
    }
}

#define XB_TMO      128
#define XB_XCNT(j)  (256  + 64 * (j))
#define XB_XSUB(j)  (1280 + 64 * (j))
#define XB_XGEN(j)  (2304 + 64 * (j))
#define XB_TOP      3328
#define XB_TOPGEN   3392
#define XCD_BAR_WORDS 3456
#define XB_SPIN_CAP (1u << 18)
__device__ __forceinline__ unsigned xb_ld(unsigned* p)              { return __hip_atomic_load(p, __ATOMIC_RELAXED, __HIP_MEMORY_SCOPE_AGENT); }
__device__ __forceinline__ unsigned xb_add(unsigned* p, unsigned v) { return __hip_atomic_fetch_add(p, v, __ATOMIC_RELAXED, __HIP_MEMORY_SCOPE_AGENT); }
__device__ __forceinline__ unsigned xb_xcc_id() { return (unsigned)__builtin_amdgcn_s_getreg((3 << 11) | 20) & 0xFu; }
#define XB_SPIN(cond, bar) do { unsigned _sp = 0; while (cond) { __builtin_amdgcn_s_sleep(1); \
    if ((++_sp & 255u) == 0u) { if (xb_ld(&(bar)[XB_TMO])) break; if (_sp > XB_SPIN_CAP) { atomicAdd(&(bar)[XB_TMO], 1u); break; } } } } while (0)
__device__ __forceinline__ void xcd_barrier_complete(unsigned* bar, unsigned x, unsigned& nloc, unsigned& nx) {
    const unsigned G = gridDim.x * gridDim.y * gridDim.z;
    unsigned sum, cnt, mine, sp = 0u;
    for (;;) {
        sum = 0u; cnt = 0u; mine = 0u;
#pragma unroll
        for (unsigned j = 0; j < 16; ++j) { const unsigned c = xb_ld(&bar[XB_XCNT(j)]); sum += c; cnt += (c > 0u) ? 1u : 0u; mine = (j == x) ? c : mine; }
        if (sum == G) break;
        __builtin_amdgcn_s_sleep(1);
        if ((++sp & 255u) == 0u) { if (xb_ld(&bar[XB_TMO])) break; if (sp > XB_SPIN_CAP) { atomicAdd(&bar[XB_TMO], 1u); break; } }
    }
    nloc = mine > 0u ? mine : 1u; nx = cnt > 0u ? cnt : 1u;
}
__device__ __forceinline__ void xcd_barrier(unsigned* bar, volatile LAS unsigned* st, bool leader) {
    asm volatile("s_waitcnt vmcnt(0)" ::: "memory");
    __syncthreads();
    if (leader) {
        const unsigned x = xb_xcc_id();
        __builtin_amdgcn_s_waitcnt(0);
        unsigned nloc = st[0], nx = st[1];
        if (nloc == 0u) { xcd_barrier_complete(bar, x, nloc, nx); st[0] = nloc; st[1] = nx; }
        const unsigned old = xb_add(&bar[XB_XSUB(x)], 1u);
        const unsigned gen = old / nloc;
        if (old + 1u == (gen + 1u) * nloc) {
            __builtin_amdgcn_fence(__ATOMIC_RELEASE, "agent");
            asm volatile("s_waitcnt vmcnt(0)" ::: "memory");
            const unsigned og = xb_add(&bar[XB_TOP], 1u);
            const unsigned tg = og / nx;
            if (og + 1u == (tg + 1u) * nx) xb_add(&bar[XB_TOPGEN], 1u);
            else XB_SPIN(xb_ld(&bar[XB_TOPGEN]) == tg, bar);
            __builtin_amdgcn_fence(__ATOMIC_ACQUIRE, "agent");
            xb_add(&bar[XB_XGEN(x)], 1u);
            asm volatile("s_waitcnt vmcnt(0)" ::: "memory");
        } else {
            XB_SPIN(xb_ld(&bar[XB_XGEN(x)]) == gen, bar);
            __builtin_amdgcn_fence(__ATOMIC_ACQUIRE, "agent");
            asm volatile("s_waitcnt vmcnt(0)" ::: "memory");
        }
    }
    __syncthreads();
}

enum { T_PRO = 0, T_GU, T_DOWN, T_PROJ, T_MIXE, T_SCAN, T_S3, T_WOUT, T_MIXO };
#ifndef DUP_MASK
#define DUP_MASK 0u
#endif
constexpr int NBASE = 17;
__host__ __device__ __forceinline__ void base_info(int ph, int& type, int& layer, int& ffn) {
    if (ph == 0) { type = T_PRO; layer = 0; ffn = 0; return; }
    if (ph <= 9) { layer = 0; const int r = ph - 1; type = r == 0 ? T_GU : r == 1 ? T_DOWN : r == 2 ? T_PROJ : r == 3 ? T_MIXE : r == 4 ? T_SCAN : r == 5 ? T_S3 : r == 6 ? T_WOUT : r == 7 ? T_GU : T_DOWN; ffn = r >= 7; return; }
    layer = 1; const int r = ph - 10; type = r == 0 ? T_GU : r == 1 ? T_DOWN : r == 2 ? T_PROJ : r == 3 ? T_MIXO : r == 4 ? T_WOUT : r == 5 ? T_GU : T_DOWN; ffn = r >= 5;
}
__host__ __device__ __forceinline__ int phase_info(int ph, int& type, int& layer, int& ffn, int& dup) {
    int k = 0;
    for (int b = 0; b < NBASE; ++b) { base_info(b, type, layer, ffn); const int reps = ((DUP_MASK >> type) & 1u) ? 2 : 1; if (ph < k + reps) { dup = ph - k; return -1; } k += reps; }
    return k;
}

__global__ void __launch_bounds__(NTHREADS, 2) fwd(Args args) {
    extern __shared__ __attribute__((aligned(16))) unsigned char lds_raw[];
    if (threadIdx.x < 34) ((LAS unsigned long long*)((LAS unsigned char*)lds_raw + TAB_OFF))[threadIdx.x] = (unsigned long long)args.in[threadIdx.x];
    if (threadIdx.x == 64) { volatile LAS unsigned* st = (volatile LAS unsigned*)((LAS unsigned char*)lds_raw + TAB_OFF + 384); st[0] = 0u; st[1] = 0u; }
    if (threadIdx.x == 0 && args.ph_hi - args.ph_lo > 2) (void)xb_add(&((unsigned*)args.ws)[XB_XCNT(xb_xcc_id())], 1u);
    __syncthreads();
    const int wave_s = __builtin_amdgcn_readfirstlane(threadIdx.x >> 6);
    int ph0 = args.ph_lo;
    if (ph0 == 0) {
        Ctx c; c.lds = (LAS unsigned char*)lds_raw; c.tid = threadIdx.x; c.lane = c.tid & 63; c.wave = wave_s; c.fr = c.lane & 15; c.fq = c.lane >> 4;
        c.tab = (const LAS unsigned long long*)(c.lds + TAB_OFF); c.out = args.out; c.ws = args.ws; c.dry = 0;
        c.XB = (bf16_t*)(args.ws + WS_XB); c.RSP = (float*)(args.ws + WS_RSP); c.DT = (float*)(args.ws + WS_DT); c.CDEC = (float*)(args.ws + WS_CDEC); c.BIG = (bf16_t*)(args.ws + WS_BIG);
        phase_prologue(c, (int)gridDim.x);
        if (args.ph_hi > 1) cg::this_grid().sync();
        ph0 = 1;
    }
    for (int ph = ph0; ph < args.ph_hi; ++ph) {
        int lane_; asm volatile("v_mbcnt_lo_u32_b32 %0, -1, 0\n\tv_mbcnt_hi_u32_b32 %0, -1, %0" : "=v"(lane_));
        int wv_ = wave_s; asm volatile("" : "+s"(wv_));
        const int tid_ = wv_ * 64 + lane_;
        unsigned long long wsi_ = (unsigned long long)args.ws, outi_ = (unsigned long long)args.out; int G = gridDim.x; asm volatile("" : "+s"(wsi_), "+s"(outi_), "+s"(G));
        unsigned char* ws_ = (unsigned char*)(GAS unsigned char*)wsi_; float* out_ = (float*)(GAS float*)outi_;
        Ctx c; c.lds = (LAS unsigned char*)lds_raw; c.tid = tid_; c.lane = c.tid & 63; c.wave = wv_; c.fr = c.lane & 15; c.fq = c.lane >> 4;
        c.tab = (const LAS unsigned long long*)(c.lds + TAB_OFF); c.out = out_; c.ws = ws_; c.dry = 0;
        c.XB = (bf16_t*)(ws_ + WS_XB); c.RSP = (float*)(ws_ + WS_RSP); c.DT = (float*)(ws_ + WS_DT); c.CDEC = (float*)(ws_ + WS_CDEC); c.BIG = (bf16_t*)(ws_ + WS_BIG);
        int type, layer, ffn, dup; (void)phase_info(ph, type, layer, ffn, dup); c.dry = dup;
        if (type == T_GU) {
            pg8::Gemm g{c.XB, (const bf16_t*)(c.ws + WS_WGU + (size_t)(layer * 2 + ffn) * SZ_WGU), DM, MT, 5632, DM};
            pg8::StaticOrder S; S.init(MT, 5632, G, (int)blockIdx.x); pg8::EpiGU E{c.BIG, c.RSP};
            pg8::gemm_phase<pg8::EpiGU>(c.lds, g, S, E, c.tid);
            { const unsigned jm = dup ? 0u : (layer == 0 ? (ffn == 0 ? JOBS_GU_L0F1 : JOBS_GU_L0F2) : (ffn == 0 ? JOBS_GU_L1F1 : 0u));
              if (jm != 0u) { const int nfull = S.nwg % G; const Ctx c2 = fresh_lane(c);
                  if (nfull == 0 || G - nfull < 64) convert_jobs(c2, jm, (int)blockIdx.x, G);
                  else if ((int)blockIdx.x >= nfull) convert_jobs(c2, jm, (int)blockIdx.x - nfull, G - nfull); } }
        } else if (type == T_DOWN || type == T_WOUT) {
            const float alpha = dup ? 0.f : (type == T_DOWN ? 0.5f : 1.0f);
            float* OUTF = (type == T_DOWN && layer == 1 && ffn == 1) ? c.out : nullptr;
            pg8::Gemm g;
            if (type == T_DOWN) { const bf16_t* W = (const bf16_t*)(c.ws + WS_WDN + (size_t)(layer * 2 + ffn) * SZ_WDN);
                mini_res_gemm<11>(c, c.BIG + (size_t)MP * DFF, DFF, W, alpha, G, OUTF); g = pg8::Gemm{c.BIG, W, DFF, MP, DM, DFF}; }
            else { const bf16_t* W = (const bf16_t*)(c.ws + (layer == 0 ? WS_WOUTE : WS_WOUTO)); const int pitch = layer == 0 ? EV_PITCH : OD_PITCH;
                mini_res_gemm<8>(c, c.BIG + (size_t)MP * pitch, pitch, W, alpha, G, OUTF); g = pg8::Gemm{c.BIG, W, pitch, MP, DM, 2048}; }
            pg8::StaticOrder S; S.init(MP, DM, G, (int)blockIdx.x); pg8::EpiRes E{OUTF, c.XB, c.RSP, alpha};
            pg8::gemm_phase<pg8::EpiRes>(c.lds, g, S, E, c.tid);
        } else if (type == T_PROJ) {
            pg8::Gemm g; pg8::EpiProj E; int N;
            if (layer == 0) { N = EV_N; g = pg8::Gemm{c.XB, (const bf16_t*)(c.ws + WS_WINE), DM, MT, EV_N, DM}; E = pg8::EpiProj{c.BIG, EV_PITCH, 0, c.RSP, 0x00F0Fu, c.DT, 18}; }
            else { N = OD_N; g = pg8::Gemm{c.XB, (const bf16_t*)(c.ws + WS_WINO), DM, MT, OD_N, DM}; E = pg8::EpiProj{c.BIG, OD_PITCH, 1024, c.RSP, 0u, nullptr, -1}; }
            pg8::StaticOrder S; S.init(MT, N, G, (int)blockIdx.x);
            pg8::gemm_phase<pg8::EpiProj>(c.lds, g, S, E, c.tid);
            { const unsigned jm = dup ? 0u : (layer == 0 ? JOBS_PROJ_L0 : JOBS_PROJ_L1); const int nfull = S.nwg % G; const Ctx c2 = fresh_lane(c);
              if (nfull == 0 || G - nfull < 64) convert_jobs(c2, jm, (int)blockIdx.x, G);
              else if ((int)blockIdx.x >= nfull) convert_jobs(c2, jm, (int)blockIdx.x - nfull, G - nfull); }
        } else if (type == T_MIXE) {
            for (int u = blockIdx.x; u < 256 + 512 + 256 + 128; u += G) { const Ctx cu = relaunder(c);
                if (u < 256) gmlp_unit(cu, u); else if (u < 768) ssd_s1_unit(cu, u - 256); else if (u < 1024) ssd_sample_unit(cu, u - 768); else gmlp_sample_unit(cu, u - 1024);
            }
            for (int idx = blockIdx.x * NTHREADS + c.tid; idx < 8 * 3 * 1536; idx += G * NTHREADS) { const int col = idx % 1536, r = (idx / 1536) % 3, b = idx / 4608;
                c.out[O_CONV_P + idx] = bf2f(c.BIG[((size_t)b * 4096 + 4093 + r) * EV_PITCH + 3072 + col]); }
        } else if (type == T_SCAN) {
            for (int u = blockIdx.x; u < 512; u += G) { const Ctx cu = relaunder(c); ssd_scan_unit(cu, u); }
        } else if (type == T_S3) {
            for (int u = blockIdx.x; u < 512; u += G) { const Ctx cu = relaunder(c); ssd_s3_unit(cu, u); }
        } else if (type == T_MIXO) {
            for (int u = blockIdx.x; u < 1024 + 1040; u += G) { const Ctx cu = relaunder(c);
                if (u < 1024) attn_prompt_unit(cu, u); else pool_unit(cu, u - 1024);
            }
            { const int nb = (G >= 64) ? 16 : 0;
              if ((int)blockIdx.x >= nb) for (int m = (int)blockIdx.x - nb; m < 512; m += G - nb) { const Ctx cu = relaunder(c); attn_sample_unit(cu, m); } }
            { const ArgsView a{{c.tab}}; const float* sp = a.in[I_POOL];
              for (int idx = blockIdx.x * NTHREADS + c.tid; idx < 128 * 15 * 256; idx += G * NTHREADS) { const int cq = idx & 255, r = (idx >> 8) % 15, bb = idx / (15 * 256); f32x4 v;
                  if (r < 11) v = *(const f32x4*)(sp + ((size_t)bb * 15 + r + 4) * 1024 + 4 * cq);
                  else { const u32x2 w = *(const u32x2*)(c.BIG + ((size_t)MP + 4 * bb + (r - 11)) * OD_PITCH + OD_N + 4 * cq); v = (f32x4){bflo(w.x), bfhi(w.x), bflo(w.y), bfhi(w.y)}; }
                  *(f32x4*)(c.out + O_POOL_S + ((size_t)bb * 15 + r) * 1024 + 4 * cq) = v; }
              for (int idx = blockIdx.x * NTHREADS + c.tid; idx < 8 * 15 * 256; idx += G * NTHREADS) { const int cq = idx & 255, r = (idx >> 8) % 15, b = idx / (15 * 256);
                  const u32x2 w = *(const u32x2*)(c.BIG + ((size_t)b * 4096 + 4081 + r) * OD_PITCH + OD_N + 4 * cq);
                  *(f32x4*)(c.out + O_POOL_P + ((size_t)b * 15 + r) * 1024 + 4 * cq) = (f32x4){bflo(w.x), bfhi(w.x), bflo(w.y), bfhi(w.y)}; } }
        }
        if (ph + 1 < args.ph_hi) {
            int l2_; asm volatile("v_mbcnt_lo_u32_b32 %0, -1, 0\n\tv_mbcnt_hi_u32_b32 %0, -1, %0" : "=v"(l2_));
            int w2_ = wave_s; asm volatile("" : "+s"(w2_));
            unsigned long long wsb_ = (unsigned long long)args.ws; asm volatile("" : "+s"(wsb_));
            xcd_barrier((unsigned*)(GAS unsigned*)wsb_, (volatile LAS unsigned*)((LAS unsigned char*)lds_raw + TAB_OFF + 384), (w2_ == 0) && (l2_ == 0));
        }
    }
}

#ifndef MK_ONE_LAUNCH
#define MK_ONE_LAUNCH 1
#endif
extern "C" void kernel_launch(void* const* d_in, const int* in_sizes, int n_in, void* d_out, int out_size, void* d_ws, size_t ws_size, hipStream_t stream) {
    static int grid = 0;
    if (grid == 0) {
        int dev = 0, cus = 0, per_cu = 0;
        hipGetDevice(&dev); hipDeviceGetAttribute(&cus, hipDeviceAttributeMultiprocessorCount, dev);
        hipFuncSetAttribute((const void*)fwd, hipFuncAttributeMaxDynamicSharedMemorySize, LDS_BYTES);
        if (hipOccupancyMaxActiveBlocksPerMultiprocessor(&per_cu, (const void*)fwd, NTHREADS, LDS_BYTES) != hipSuccess || per_cu < 1) per_cu = 1;
        (void)hipGetLastError();
        grid = cus * per_cu;
        if (n_in != 34 || (size_t)out_size != O_END || ws_size < WS_END) fprintf(stderr, "kernel_launch: unexpected sizes n_in %d out %d ws %zu (need %zu)\n", n_in, out_size, ws_size, (size_t)WS_END);
    }
    Args a{};
    for (int i = 0; i < 34; ++i) a.in[i] = (const float*)d_in[i];
    a.out = (float*)d_out; a.ws = (unsigned char*)d_ws;
#if MK_ONE_LAUNCH
    { int t_, l_, f_, d_; a.ph_lo = 0; a.ph_hi = phase_info(1 << 20, t_, l_, f_, d_); }
    (void)hipMemsetAsync(d_ws, 0, 16384, stream);
    void* kargs[] = {&a};
    hipError_t e = hipLaunchCooperativeKernel((const void*)fwd, dim3(grid), dim3(NTHREADS), kargs, LDS_BYTES, stream);
    if (e != hipSuccess) fprintf(stderr, "cooperative launch failed: %s (grid %d)\n", hipGetErrorString(e), grid);
#else
    int t_, l_, f_, d_; const int NPHASES = phase_info(1 << 20, t_, l_, f_, d_);
    for (int ph = 0; ph < NPHASES; ++ph) { a.ph_lo = ph; a.ph_hi = ph + 1; hipLaunchKernelGGL(fwd, dim3(grid), dim3(NTHREADS), LDS_BYTES, stream, a); }
#endif
}
```
